# Optimizing an MI355X kernel written in HIP

```python
import jax, jax.numpy as jnp
from jax import lax
import numpy as np

D_MODEL = 1024
BATCH = 4
SEQ = 8192
DEPTH = 4

CHUNK = 64
D_MIX = D_MODEL
N_GROUPS = 4
GW = D_MIX // N_GROUPS
HEAD_DIM = 64
N_HEADS_GROUP = GW // HEAD_DIM
ATTN_LEFT_CHUNKS = 8
N_BAND = ATTN_LEFT_CHUNKS + 1
REL_CLIP = 256
ATTN_SCALE = HEAD_DIM ** -0.5
NEG_INF = -1e30
RWKV_W_RANK = 32
RWKV_A_RANK = 32
RWKV_G_RANK = 64
RWKV_GN_EPS = HEAD_DIM * 1e-5
LRU_CONV = 4
LRU_C = 8.0
LRU_BLOCKS = N_HEADS_GROUP
LRU_BLOCK_DIM = GW // LRU_BLOCKS
ATTN_COLS = 3 * GW
HGRN_COLS = 4 * GW
RWKV_COLS = 3 * GW + RWKV_W_RANK + RWKV_A_RANK + RWKV_G_RANK
LRU_COLS = 2 * GW
D_IN = ATTN_COLS + HGRN_COLS + RWKV_COLS + LRU_COLS
MLP_HIDDEN = 4 * D_MODEL
RMS_EPS = 1e-6

kernel_name = 'hybrid_chunk_causal_block'


def split_cols(t, sizes):
    offs = np.cumsum(sizes)[:-1].tolist()
    return jnp.split(t, offs, axis=-1)


def rms_norm(x, gain):
    xf = x.astype(jnp.float32)
    y = xf * lax.rsqrt(jnp.mean(xf * xf, axis=-1, keepdims=True) + RMS_EPS)
    return (y * gain.astype(jnp.float32)).astype(x.dtype)


def to_heads(t):
    return t.reshape(t.shape[0], t.shape[1], N_HEADS_GROUP, HEAD_DIM)


def to_chunks(t):
    b, s, _ = t.shape
    return t.reshape(b, s // CHUNK, CHUNK, N_HEADS_GROUP, HEAD_DIM).transpose(1, 0, 3, 2, 4)


def from_chunks(t):
    nc, b = t.shape[0], t.shape[1]
    return t.transpose(1, 0, 3, 2, 4).reshape(b, nc * CHUNK, GW)


def chunk_attention(q, k, v, rel_bias):
    b, s, _ = q.shape
    nc = s // CHUNK
    shp = (b, nc, CHUNK, N_HEADS_GROUP, HEAD_DIM)
    qc, kc, vc = q.reshape(shp), k.reshape(shp), v.reshape(shp)
    pad = ((0, 0), (ATTN_LEFT_CHUNKS, 0), (0, 0), (0, 0), (0, 0))
    band = jnp.arange(nc)[:, None] + jnp.arange(N_BAND)[None, :]
    kb = jnp.pad(kc, pad)[:, band].reshape(b, nc, N_BAND * CHUNK, N_HEADS_GROUP, HEAD_DIM)
    vb = jnp.pad(vc, pad)[:, band].reshape(b, nc, N_BAND * CHUNK, N_HEADS_GROUP, HEAD_DIM)
    scores = jnp.einsum('bcqhd,bckhd->bchqk', qc, kb) * ATTN_SCALE
    key_off = ((jnp.arange(N_BAND) - ATTN_LEFT_CHUNKS)[:, None] * CHUNK
               + jnp.arange(CHUNK)[None, :]).reshape(-1)
    rel = key_off[None, :] - jnp.arange(CHUNK)[:, None]
    bias = rel_bias.astype(jnp.float32)[:, jnp.clip(rel, -REL_CLIP, REL_CLIP) + REL_CLIP]
    valid = jnp.repeat(band >= ATTN_LEFT_CHUNKS, CHUNK, axis=1)
    scores = jnp.where(valid[None, :, None, None, :], scores + bias[None, None], NEG_INF)
    probs = jax.nn.softmax(scores, axis=-1)
    out = jnp.einsum('bchqk,bckhd->bcqhd', probs, vb)
    return out.reshape(b, s, GW)


def hgrn2(q_raw, f_raw, i_raw, g_raw, lb, norm_gain):
    b = q_raw.shape[0]
    log_f = jnp.logaddexp(jnp.log(lb), jnp.log1p(-lb) + jax.nn.log_sigmoid(f_raw))
    key = (1.0 - lb) * jax.nn.sigmoid(-f_raw)
    q = jax.nn.silu(q_raw)
    tri = jnp.tril(jnp.ones((CHUNK, CHUNK), dtype=bool))

    def step(state, inp):
        qc, kc, vc, gc = inp
        cum = jnp.cumsum(gc, axis=2)
        last = cum[:, :, -1:, :]
        o_inter = jnp.einsum('bhtk,bhkv->bhtv', qc * jnp.exp(cum), state)
        diff = cum[:, :, :, None, :] - cum[:, :, None, :, :]
        decay = jnp.exp(jnp.where(tri[None, None, :, :, None], diff, -jnp.inf))
        att = jnp.einsum('bhtk,bhsk,bhtsk->bhts', qc, kc, decay)
        o_intra = jnp.einsum('bhts,bhsv->bhtv', att, vc)
        new_state = (jnp.exp(last).transpose(0, 1, 3, 2) * state
                     + jnp.einsum('bhsk,bhsv->bhkv', kc * jnp.exp(last - cum), vc))
        return new_state, o_inter + o_intra

    state0 = jnp.zeros((b, N_HEADS_GROUP, HEAD_DIM, HEAD_DIM), jnp.float32)
    _, o = lax.scan(step, state0, (to_chunks(q), to_chunks(key), to_chunks(i_raw), to_chunks(log_f)))
    o = to_heads(from_chunks(o))
    o = o * lax.rsqrt(jnp.mean(o * o, axis=-1, keepdims=True) + RMS_EPS)
    return o.reshape(g_raw.shape) * norm_gain * jax.nn.silu(g_raw)


def rwkv7(pc, mu, w0, w2, a0, a2, g2, k_k, k_a, r_k, ln_w, ln_b):
    b, s, _ = pc.shape
    prev = jnp.pad(pc, ((0, 0), (1, 0), (0, 0)))[:, :-1]
    xs = pc + mu * (prev - pc)
    r, k, v, w_lo, a_lo, g_lo = split_cols(xs, [GW, GW, GW, RWKV_W_RANK, RWKV_A_RANK, RWKV_G_RANK])
    w_pre = -jax.nn.softplus(-(w0 + jnp.tanh(w_lo) @ w2)) - 0.5
    decay = jnp.exp(-jnp.exp(w_pre))
    a = jax.nn.sigmoid(a0 + a_lo @ a2)
    g = jax.nn.sigmoid(g_lo) @ g2
    kk = to_heads(k * k_k)
    kk = kk / jnp.maximum(jnp.sqrt(jnp.sum(kk * kk, axis=-1, keepdims=True)), 1e-12)
    k = k * (1.0 + (a - 1.0) * k_a)
    r_h, w_h, k_h, v_h, a_h = to_heads(r), to_heads(decay), to_heads(k), to_heads(v), to_heads(a)

    def step(state, inp):
        rt, wt, kt, vt, kkt, at = inp
        sa = jnp.einsum('bhvk,bhk->bhv', state, -kkt)
        state = (state * wt[:, :, None, :] + sa[..., None] * (kkt * at)[:, :, None, :]
                 + vt[..., None] * kt[:, :, None, :])
        return state, jnp.einsum('bhvk,bhk->bhv', state, rt)

    seq_first = lambda t: t.transpose(1, 0, 2, 3)
    state0 = jnp.zeros((b, N_HEADS_GROUP, HEAD_DIM, HEAD_DIM), jnp.float32)
    _, y = lax.scan(step, state0, (seq_first(r_h), seq_first(w_h), seq_first(k_h),
                                   seq_first(v_h), seq_first(kk), seq_first(a_h)))
    y = seq_first(y)
    mean = jnp.mean(y, axis=-1, keepdims=True)
    var = jnp.mean(jnp.square(y - mean), axis=-1, keepdims=True)
    y = ((y - mean) * lax.rsqrt(var + RWKV_GN_EPS)).reshape(b, s, GW) * ln_w + ln_b
    bonus = (jnp.sum(r_h * k_h * r_k, axis=-1, keepdims=True) * v_h).reshape(b, s, GW)
    return (y + bonus) * g


def rglru(xb, gb, conv_w, conv_b, wa, ba, wx, bx, lam):
    b, s, _ = xb.shape
    conv = lax.conv_general_dilated(xb, conv_w.astype(xb.dtype)[:, None, :], window_strides=(1,),
                                    padding=[(LRU_CONV - 1, 0)],
                                    dimension_numbers=('NWC', 'WIO', 'NWC'),
                                    feature_group_count=GW) + conv_b
    xh = conv.reshape(b, s, LRU_BLOCKS, LRU_BLOCK_DIM)
    gate_r = jax.nn.sigmoid(jnp.einsum('bsnd,nde->bsne', xh, wa).reshape(b, s, GW) + ba)
    gate_i = jax.nn.sigmoid(jnp.einsum('bsnd,nde->bsne', xh, wx).reshape(b, s, GW) + bx)
    log_a = -LRU_C * gate_r * jax.nn.softplus(-lam)
    a = jnp.exp(log_a)
    inp = jnp.sqrt(-jnp.expm1(2.0 * log_a)) * (gate_i * conv)

    def combine(c1, c2):
        a1, b1 = c1
        a2, b2 = c2
        return a1 * a2, a2 * b1 + b2

    _, h = lax.associative_scan(combine, (a, inp), axis=1)
    return h * jax.nn.gelu(gb)


def setup_inputs(seed: int = 0) -> dict:
    key = jax.random.key(seed)
    ks = jax.random.split(key, 32)
    L = DEPTH

    def nrm(k, shape, scale):
        return jax.random.normal(k, shape, jnp.float32) * scale

    u = jax.random.uniform(ks[27], (L, GW), jnp.float32, 0.9, 0.999)
    a_root = u ** (1.0 / LRU_C)
    lam = jnp.log(a_root) - jnp.log1p(-a_root)
    return {
        'x': nrm(ks[0], (BATCH, SEQ, D_MODEL), 1.0),
        'norm_mix_pre': 1.0 + nrm(ks[1], (L, D_MODEL), 0.05),
        'norm_mix_post': 1.0 + nrm(ks[2], (L, D_MODEL), 0.05),
        'norm_mlp_pre': 1.0 + nrm(ks[3], (L, D_MODEL), 0.05),
        'norm_mlp_post': 1.0 + nrm(ks[4], (L, D_MODEL), 0.05),
        'w_in': nrm(ks[5], (L, D_MODEL, D_IN), D_MODEL ** -0.5),
        'w_out': nrm(ks[6], (L, D_MIX, D_MODEL), D_MIX ** -0.5),
        'attn_rel_bias': nrm(ks[7], (L, N_HEADS_GROUP, 2 * REL_CLIP + 1), 0.2),
        'hgrn_lb_logits': nrm(ks[8], (L, GW), 0.5),
        'hgrn_norm': 1.0 + nrm(ks[9], (L, GW), 0.05),
        'rwkv_mu': jax.random.uniform(ks[10], (L, RWKV_COLS), jnp.float32, 0.2, 0.8),
        'rwkv_w0': jax.random.uniform(ks[11], (L, GW), jnp.float32, -6.0, 1.0),
        'rwkv_w2': nrm(ks[12], (L, RWKV_W_RANK, GW), 0.5 * RWKV_W_RANK ** -0.5),
        'rwkv_a0': nrm(ks[13], (L, GW), 0.1),
        'rwkv_a2': nrm(ks[14], (L, RWKV_A_RANK, GW), 0.5 * RWKV_A_RANK ** -0.5),
        'rwkv_g2': nrm(ks[15], (L, RWKV_G_RANK, GW), RWKV_G_RANK ** -0.5),
        'rwkv_k_k': 0.85 + nrm(ks[16], (L, GW), 0.05),
        'rwkv_k_a': 1.0 + nrm(ks[17], (L, GW), 0.05),
        'rwkv_r_k': nrm(ks[18], (L, N_HEADS_GROUP, HEAD_DIM), 0.1),
        'rwkv_ln_w': 1.0 + nrm(ks[19], (L, GW), 0.05),
        'rwkv_ln_b': nrm(ks[20], (L, GW), 0.02),
        'lru_conv_w': nrm(ks[21], (L, LRU_CONV, GW), 0.5 * LRU_CONV ** -0.5),
        'lru_conv_b': nrm(ks[22], (L, GW), 0.02),
        'lru_wa': nrm(ks[23], (L, LRU_BLOCKS, LRU_BLOCK_DIM, LRU_BLOCK_DIM), LRU_BLOCK_DIM ** -0.5),
        'lru_ba': nrm(ks[24], (L, GW), 0.02),
        'lru_wx': nrm(ks[25], (L, LRU_BLOCKS, LRU_BLOCK_DIM, LRU_BLOCK_DIM), LRU_BLOCK_DIM ** -0.5),
        'lru_bx': nrm(ks[26], (L, GW), 0.02),
        'lru_lambda': lam,
        'mlp_w1': nrm(ks[28], (L, D_MODEL, MLP_HIDDEN), D_MODEL ** -0.5),
        'mlp_w2': nrm(ks[29], (L, MLP_HIDDEN, D_MODEL), MLP_HIDDEN ** -0.5),
    }


def reference(x, norm_mix_pre, norm_mix_post, norm_mlp_pre, norm_mlp_post, w_in, w_out,
              attn_rel_bias, hgrn_lb_logits, hgrn_norm, rwkv_mu, rwkv_w0, rwkv_w2, rwkv_a0, rwkv_a2,
              rwkv_g2, rwkv_k_k, rwkv_k_a, rwkv_r_k, rwkv_ln_w, rwkv_ln_b, lru_conv_w, lru_conv_b,
              lru_wa, lru_ba, lru_wx, lru_bx, lru_lambda, mlp_w1, mlp_w2):
    dt = x.dtype
    f32 = jnp.float32
    lb_sm = jax.nn.softmax(hgrn_lb_logits.astype(f32), axis=0)
    lb_all = jnp.maximum(jnp.cumsum(lb_sm, axis=0) - lb_sm[0:1], 0.0)
    for l in range(DEPTH):
        h = rms_norm(x, norm_mix_pre[l])
        proj = (h @ w_in[l]).astype(f32)
        pa, pb, pc, pd = split_cols(proj, [ATTN_COLS, HGRN_COLS, RWKV_COLS, LRU_COLS])
        qa, ka, va = split_cols(pa, [GW, GW, GW])
        ya = chunk_attention(qa, ka, va, attn_rel_bias[l])
        qb, fb, ib, gb = split_cols(pb, [GW, GW, GW, GW])
        yb = hgrn2(qb, fb, ib, gb, lb_all[l], hgrn_norm[l].astype(f32))
        yc = rwkv7(pc, rwkv_mu[l].astype(f32), rwkv_w0[l].astype(f32), rwkv_w2[l].astype(f32),
                   rwkv_a0[l].astype(f32), rwkv_a2[l].astype(f32), rwkv_g2[l].astype(f32),
                   rwkv_k_k[l].astype(f32), rwkv_k_a[l].astype(f32), rwkv_r_k[l].astype(f32),
                   rwkv_ln_w[l].astype(f32), rwkv_ln_b[l].astype(f32))
        xd, gd = split_cols(pd, [GW, GW])
        yd = rglru(xd, gd, lru_conv_w[l].astype(f32), lru_conv_b[l].astype(f32), lru_wa[l].astype(f32),
                   lru_ba[l].astype(f32), lru_wx[l].astype(f32), lru_bx[l].astype(f32),
                   lru_lambda[l].astype(f32))
        mix = jnp.concatenate([ya, yb, yc, yd], axis=-1).astype(dt)
        x = x + rms_norm(mix @ w_out[l], norm_mix_post[l])
        h = rms_norm(x, norm_mlp_pre[l])
        ff = jnp.square(jax.nn.relu(h @ mlp_w1[l])) @ mlp_w2[l]
        x = x + rms_norm(ff, norm_mlp_post[l])
    return x
```

```cpp
#include <hip/hip_runtime.h>
#include <hip/hip_cooperative_groups.h>
#include <cstdio>
namespace cg = cooperative_groups;

#ifndef MEGA
#define MEGA 1
#endif
#ifndef DUP
#define DUP 0
#endif

typedef unsigned short bf16_t;
typedef short bf16x8 __attribute__((ext_vector_type(8)));
typedef short bf16x4 __attribute__((ext_vector_type(4)));
typedef float f32x4 __attribute__((ext_vector_type(4)));
typedef float f32x2 __attribute__((ext_vector_type(2)));

constexpr int T = 32768, SEQ = 8192, DIN = 3200, DINP = 3328;
constexpr size_t MiB = 1u << 20;
constexpr size_t OFF_WIN = 0;
constexpr size_t OFF_WOUT = OFF_WIN + (size_t)DINP * 1024 * 2;
constexpr size_t OFF_W1 = OFF_WOUT + (size_t)1024 * 1024 * 2;
constexpr size_t OFF_W2 = OFF_W1 + (size_t)4096 * 1024 * 2;
constexpr size_t OFF_PH = 26 * MiB;
constexpr size_t OFF_HU = OFF_PH + 200 * MiB;
constexpr size_t OFF_MIX = OFF_PH + 256 * MiB;
constexpr size_t OFF_XB = OFF_MIX + 64 * MiB;
constexpr size_t OFF_LP = OFF_XB + 16 * MiB;
constexpr size_t OFF_RW = OFF_XB + 64 * MiB;
constexpr size_t OFF_SM = OFF_RW + 96 * MiB;
constexpr size_t SM_RINV = 0, SM_LB = 128 * 1024, SM_DEC = 256 * 1024, SM_HEND = 1 * MiB, SM_PTOT = 2 * MiB, SM_CARRY = 3 * MiB;
constexpr int LDS_BYTES = 131072 + 16;
constexpr size_t SM_BAR = 4 * MiB, SM_CNT = 4 * MiB + 16384;

struct Params { const float* in[30]; float* out; char* ws; };
struct Ctx { int tid, bid, nb, z; char* ws; float* out; };
__device__ __forceinline__ char* wbase(const Ctx& cx, int l) { return (l & 1) ? ((char*)cx.out + 80 * (size_t)(1u << 20)) : cx.ws; }

__device__ __forceinline__ float bf2f(bf16_t h) { return __uint_as_float(((unsigned)h) << 16); }
__device__ __forceinline__ unsigned pk_bf16(float lo, float hi) { unsigned r; asm("v_cvt_pk_bf16_f32 %0, %1, %2" : "=v"(r) : "v"(lo), "v"(hi)); return r; }
__device__ __forceinline__ bf16_t f2bf(float f) { return (bf16_t)(pk_bf16(f, 0.f) & 0xffffu); }
__device__ __forceinline__ float shx(float v, int lane, int m) { return __int_as_float(__builtin_amdgcn_ds_bpermute((lane ^ m) << 2, __float_as_int(v))); }
template <int CTRL> __device__ __forceinline__ float dpp_f(float x) { return __int_as_float(__builtin_amdgcn_update_dpp(0, __float_as_int(x), CTRL, 0xF, 0xF, true)); }
__device__ __forceinline__ float row16_sum(float x) {
    x += dpp_f<0xB1>(x);
    x += dpp_f<0x4E>(x);
    x += dpp_f<0x141>(x);
    x += dpp_f<0x140>(x);
    return x;
}
__device__ __forceinline__ float rdlane(float v, int l) { return __int_as_float(__builtin_amdgcn_readlane(__float_as_int(v), l)); }
__device__ __forceinline__ float wave_sum(float v) {
    v = row16_sum(v);
    return (rdlane(v, 0) + rdlane(v, 16)) + (rdlane(v, 32) + rdlane(v, 48));
}
__device__ __forceinline__ void wave_sum3(float& a, float& b, float& c) {
    a += dpp_f<0xB1>(a);  b += dpp_f<0xB1>(b);  c += dpp_f<0xB1>(c);
    a += dpp_f<0x4E>(a);  b += dpp_f<0x4E>(b);  c += dpp_f<0x4E>(c);
    a += dpp_f<0x141>(a); b += dpp_f<0x141>(b); c += dpp_f<0x141>(c);
    a += dpp_f<0x140>(a); b += dpp_f<0x140>(b); c += dpp_f<0x140>(c);
    a = (rdlane(a, 0) + rdlane(a, 16)) + (rdlane(a, 32) + rdlane(a, 48));
    b = (rdlane(b, 0) + rdlane(b, 16)) + (rdlane(b, 32) + rdlane(b, 48));
    c = (rdlane(c, 0) + rdlane(c, 16)) + (rdlane(c, 32) + rdlane(c, 48));
}
__device__ __forceinline__ float sigm(float x) { return __builtin_amdgcn_rcpf(1.0f + __expf(-x)); }


#define XB_TMO      128
#define XB_XCNT(j)  (256  + 64 * (j))
#define XB_XSUB(j)  (1280 + 64 * (j))
#define XB_XGEN(j)  (2304 + 64 * (j))
#define XB_TOP      3328
#define XB_TOPGEN   3392
#define XCD_BAR_WORDS 3456
#define XB_SPIN_CAP (1u << 18)
#define LAS __attribute__((address_space(3)))
__device__ __forceinline__ unsigned xb_ld(unsigned* p)              { return __hip_atomic_load(p, __ATOMIC_RELAXED, __HIP_MEMORY_SCOPE_AGENT); }
__device__ __forceinline__ unsigned xb_add(unsigned* p, unsigned v) { return __hip_atomic_fetch_add(p, v, __ATOMIC_RELAXED, __HIP_MEMORY_SCOPE_AGENT); }
__device__ __forceinline__ unsigned xb_xcc_id() { return (unsigned)__builtin_amdgcn_s_getreg((3 << 11) | 20) & 0xFu; }
#define XB_SPIN(cond, bar) do { unsigned _sp = 0; while (cond) { __builtin_amdgcn_s_sleep(1); \
    if ((++_sp & 255u) == 0u) { if (xb_ld(&(bar)[XB_TMO])) break; if (_sp > XB_SPIN_CAP) { atomicAdd(&(bar)[XB_TMO], 1u); break; } } } } while (0)
struct XcdBarrier { unsigned* bar; unsigned x; volatile LAS unsigned* st; };
__device__ __forceinline__ XcdBarrier xcd_barrier_post(unsigned* bar, volatile LAS unsigned* st) {
    XcdBarrier b; b.bar = bar; b.x = xb_xcc_id(); b.st = st;
    if (threadIdx.x == 0) (void)xb_add(&bar[XB_XCNT(b.x)], 1u);
    return b;
}
__device__ __forceinline__ void xcd_barrier_complete(unsigned* bar, unsigned x, unsigned& nloc, unsigned& nx) {
    const unsigned G = gridDim.x * gridDim.y * gridDim.z;
    unsigned sum, cnt, mine, sp = 0u;
    for (;;) {
        sum = 0u; cnt = 0u; mine = 0u;
#pragma unroll
        for (unsigned j = 0; j < 16; ++j) { const unsigned c = xb_ld(&bar[XB_XCNT(j)]); sum += c; cnt += (c > 0u) ? 1u : 0u; mine = (j == x) ? c : mine; }
        if (sum == G) break;
        __builtin_amdgcn_s_sleep(1);
        if ((++sp & 255u) == 0u) { if (xb_ld(&bar[XB_TMO])) break; if (sp > XB_SPIN_CAP) { atomicAdd(&bar[XB_TMO], 1u); break; } }
    }
    nloc = mine > 0u ? mine : 1u; nx = cnt > 0u ? cnt : 1u;
}
__device__ __forceinline__ void xcd_barrier(const XcdBarrier& b) {
    asm volatile("s_waitcnt vmcnt(0)" ::: "memory");
    __syncthreads();
    if (threadIdx.x == 0) {
        unsigned* bar = b.bar;
        __builtin_amdgcn_s_waitcnt(0);
        unsigned nloc = b.st[0], nx = b.st[1];
        if (nloc == 0u) { xcd_barrier_complete(bar, b.x, nloc, nx); b.st[0] = nloc; b.st[1] = nx; }
        const unsigned old = xb_add(&bar[XB_XSUB(b.x)], 1u);
        const unsigned gen = old / nloc;
        if (old + 1u == (gen + 1u) * nloc) {
            __builtin_amdgcn_fence(__ATOMIC_RELEASE, "agent");
            asm volatile("s_waitcnt vmcnt(0)" ::: "memory");
            const unsigned og = xb_add(&bar[XB_TOP], 1u);
            const unsigned tg = og / nx;
            if (og + 1u == (tg + 1u) * nx) xb_add(&bar[XB_TOPGEN], 1u);
            else XB_SPIN(xb_ld(&bar[XB_TOPGEN]) == tg, bar);
            __builtin_amdgcn_fence(__ATOMIC_ACQUIRE, "agent");
            xb_add(&bar[XB_XGEN(b.x)], 1u);
            asm volatile("s_waitcnt vmcnt(0)" ::: "memory");
        } else {
            XB_SPIN(xb_ld(&bar[XB_XGEN(b.x)]) == gen, bar);
            __builtin_amdgcn_fence(__ATOMIC_ACQUIRE, "agent");
            asm volatile("s_waitcnt vmcnt(0)" ::: "memory");
        }
    }
    __syncthreads();
}

constexpr int BM = 256, BK = 64, HALF = 128, HT = HALF * BK, NXCD = 8, WGM = 8;
__device__ __forceinline__ int lds_byte(int r, int c) {
    int st = (r >> 4) * 2 + (c >> 5), rr = r & 15, cc = c & 31, ob = rr * 64 + cc * 2;
    return st * 1024 + (ob ^ (((ob >> 9) & 1) << 5));
}
__device__ __forceinline__ void stage_rc(int b, int& R, int& C) {
    int st = b / 1024, sb = b % 1024, swz = sb ^ (((sb >> 9) & 1) << 5);
    R = (st >> 1) * 16 + swz / 64; C = (st & 1) * 32 + (swz % 64) / 2;
}
enum { EPI_PROJ = 0, EPI_FF = 1, EPI_UP = 2 };

__device__ __forceinline__ void gemm_tile(const Ctx& cx, const int EPI, const bf16_t* __restrict__ A, const bf16_t* __restrict__ Bt, const int K, const int brow, const int bcol,
                                          bf16_t* __restrict__ O, const int ldo, const int ncv, const float* __restrict__ rinv) {
    extern __shared__ __attribute__((aligned(16))) bf16_t shm[];
#define SA(b, h) (shm + ((b) * 2 + (h)) * HT)
#define SB(b, h) (shm + (4 + (b) * 2 + (h)) * HT)
#define STAGE(P, BASE, br, kt) do { const char* _ub = (const char*)(BASE) + ((size_t)(br) * (size_t)K + (size_t)(kt) * BK) * 2; \
    for (int _i = 0; _i < 2; ++_i) { unsigned _o = roff[_i]; asm volatile("" : "+v"(_o)); \
      __builtin_amdgcn_global_load_lds((const unsigned*)(_ub + _o), (unsigned*)((char*)(P) + cx.tid * 16 + _i * 8192), 16, 0, 0); } } while (0)
#define LDA(dst, b, h) for (int m = 0; m < 4; ++m) for (int k = 0; k < 2; ++k) \
    dst[m][k] = *reinterpret_cast<const bf16x8*>((char*)SA(b, h) + lds_byte(wr * 64 + m * 16 + fr, k * 32 + fq * 8))
#define LDB(dst, b, h) for (int n = 0; n < 2; ++n) for (int k = 0; k < 2; ++k) \
    dst[n][k] = *reinterpret_cast<const bf16x8*>((char*)SB(b, h) + lds_byte(wc * 32 + n * 16 + fr, k * 32 + fq * 8))
#define MMA(ai, bj, At_, Bt_) do { __builtin_amdgcn_s_setprio(1); \
    for (int m = 0; m < 4; ++m) for (int n = 0; n < 2; ++n) for (int k = 0; k < 2; ++k) \
      acc[ai][bj][m][n] = __builtin_amdgcn_mfma_f32_16x16x32_bf16(Bt_[n][k], At_[m][k], acc[ai][bj][m][n], 0, 0, 0); \
    __builtin_amdgcn_s_setprio(0); } while (0)
#define WAIT_V(n) asm volatile("s_waitcnt vmcnt(" #n ")" ::: "memory")
#define WAIT_L(n) asm volatile("s_waitcnt lgkmcnt(" #n ")" ::: "memory")
#define BAR __builtin_amdgcn_s_barrier()
#define SCHED __builtin_amdgcn_sched_barrier(0)
    const int wid = cx.tid >> 6, lane = cx.tid & 63, wr = wid >> 2, wc = wid & 3, fr = lane & 15, fq = lane >> 4;
    f32x4 acc[2][2][4][2] = {};
    bf16x8 At[4][2], B0[2][2], B1[2][2];
    const int nt = K / BK;
    unsigned roff[2];
#pragma unroll
    for (int _i = 0; _i < 2; ++_i) { int _r, _c; stage_rc(cx.tid * 16 + _i * 8192, _r, _c); roff[_i] = (unsigned)(_r * K + _c) * 2u; }
    STAGE(SB(0, 0), Bt, bcol, 0); STAGE(SA(0, 0), A, brow, 0);
    STAGE(SB(0, 1), Bt, bcol + HALF, 0); STAGE(SA(0, 1), A, brow + HALF, 0);
    if (wr == 1) BAR;
    WAIT_V(4); BAR;
    STAGE(SB(1, 0), Bt, bcol, 1); STAGE(SA(1, 0), A, brow, 1); STAGE(SB(1, 1), Bt, bcol + HALF, 1);
    WAIT_V(6); BAR;
    for (int t = 0; t < nt - 2; t += 2) {
        LDB(B0, 0, 0); SCHED; LDA(At, 0, 0); STAGE(SA(1, 1), A, brow + HALF, t + 1);
        WAIT_L(8); BAR; WAIT_L(0); MMA(0, 0, At, B0); BAR; SCHED;
        LDB(B1, 0, 1); STAGE(SB(0, 0), Bt, bcol, t + 2);
        BAR; WAIT_L(0); MMA(0, 1, At, B1); BAR;
        LDA(At, 0, 1); STAGE(SA(0, 0), A, brow, t + 2);
        BAR; WAIT_L(0); MMA(1, 0, At, B0); BAR; SCHED;
        STAGE(SB(0, 1), Bt, bcol + HALF, t + 2);
        WAIT_V(6); BAR; MMA(1, 1, At, B1); BAR;
        LDB(B0, 1, 0); SCHED; LDA(At, 1, 0); STAGE(SA(0, 1), A, brow + HALF, t + 2);
        WAIT_L(8); BAR; WAIT_L(0); MMA(0, 0, At, B0); BAR; SCHED;
        LDB(B1, 1, 1); STAGE(SB(1, 0), Bt, bcol, t + 3);
        BAR; WAIT_L(0); MMA(0, 1, At, B1); BAR;
        LDA(At, 1, 1); STAGE(SA(1, 0), A, brow, t + 3);
        BAR; WAIT_L(0); MMA(1, 0, At, B0); BAR; SCHED;
        STAGE(SB(1, 1), Bt, bcol + HALF, t + 3);
        WAIT_V(6); BAR; MMA(1, 1, At, B1); BAR;
    }
    { LDB(B0, 0, 0); LDA(At, 0, 0); STAGE(SA(1, 1), A, brow + HALF, nt - 1);
      BAR; WAIT_L(0); MMA(0, 0, At, B0); BAR;
      LDB(B1, 0, 1); BAR; WAIT_L(0); MMA(0, 1, At, B1); BAR;
      LDA(At, 0, 1); WAIT_V(4); BAR; WAIT_L(0); MMA(1, 0, At, B0); MMA(1, 1, At, B1); BAR; }
    { LDB(B0, 1, 0); LDA(At, 1, 0); WAIT_V(2); BAR; WAIT_L(0); MMA(0, 0, At, B0); BAR;
      LDB(B1, 1, 1); WAIT_V(0); BAR; WAIT_L(0); MMA(0, 1, At, B1); BAR;
      LDA(At, 1, 1); BAR; WAIT_L(0); MMA(1, 0, At, B0); MMA(1, 1, At, B1); BAR; }
    if (wr == 0) BAR;
#pragma unroll
    for (int ai = 0; ai < 2; ++ai)
#pragma unroll
        for (int m = 0; m < 4; ++m) {
            const int row = brow + ai * HALF + wr * 64 + m * 16 + fr;
            float rs = 1.0f;
            if (EPI != EPI_FF) rs = rinv[row];
            bf16_t* orow = O + (size_t)row * ldo;
#pragma unroll
            for (int bj = 0; bj < 2; ++bj)
#pragma unroll
                for (int n = 0; n < 2; ++n) {
                    const int col = bcol + bj * HALF + wc * 32 + n * 16 + fq * 4;
                    f32x4 v = acc[ai][bj][m][n];
                    if (EPI != EPI_FF) v *= rs;
                    if (EPI == EPI_UP) {
#pragma unroll
                        for (int j = 0; j < 4; ++j) { float r = fmaxf(v[j], 0.f); v[j] = r * r; }
                    }
                    if (col < ncv) { uint2 w; w.x = pk_bf16(v[0], v[1]); w.y = pk_bf16(v[2], v[3]); *(uint2*)(orow + col) = w; }
                }
        }
#undef SA
#undef SB
#undef STAGE
#undef LDA
#undef LDB
#undef MMA
}

__device__ __forceinline__ void gemm_phase(const Ctx& cx, const int EPI, const bf16_t* A, const bf16_t* Bt, int M, int N, int K, bf16_t* O, int ldo, int ncv, const float* rinv) {
    const int nM = M / BM, nN = N / BM, nwg = nM * nN;
    for (int i = 0;; ++i) {
        const long L = (long)i * cx.nb + cx.bid;
        if (L >= nwg) break;
        int wgid = (int)L;
        { const int q = nwg / NXCD, r = nwg % NXCD, xcd = wgid % NXCD, off = wgid / NXCD; wgid = (xcd < r ? xcd * (q + 1) : r * (q + 1) + (xcd - r) * q) + off; }
        const int nig = WGM * nN, gid = wgid / nig, fm = gid * WGM, gsz = (nM - fm) < WGM ? (nM - fm) : WGM;
        const int pm = fm + ((wgid % nig) % gsz), pn = (wgid % nig) / gsz;
        gemm_tile(cx, EPI, A, Bt, K, pm * BM, pn * BM, O, ldo, ncv, rinv);
        __syncthreads();
    }
}

template <int NR>
__device__ __forceinline__ void rows_do(const Params& p, const Ctx& cx, int mode, int l, int row0) {
    const bf16_t* ff = (const bf16_t*)(cx.ws + (mode == 1 ? OFF_PH : OFF_MIX));
    const float* gain = (mode == 1 ? p.in[2 + cx.z] : p.in[4 + cx.z]) + l * 1024;
    bf16_t* xb = (bf16_t*)(cx.ws + OFF_XB);
    float* rinv = (float*)(cx.ws + OFF_SM + SM_RINV);
    const int lane = cx.tid & 63;
    const bool fin = (mode == 2 && l == 3);
    float4 xv[NR][4];
    uint2 fu[NR][4];
#pragma unroll
    for (int r = 0; r < NR; ++r) {
        const size_t row = (size_t)(row0 + r);
#pragma unroll
        for (int i = 0; i < 4; ++i) {
            if (mode == 0) xv[r][i] = ((const float4*)(p.in[0 + cx.z] + row * 1024))[i * 64 + lane];
            else {
                const uint2 u = ((const uint2*)(xb + row * 1024))[i * 64 + lane];
                xv[r][i].x = __uint_as_float(u.x << 16); xv[r][i].y = __uint_as_float(u.x & 0xffff0000u);
                xv[r][i].z = __uint_as_float(u.y << 16); xv[r][i].w = __uint_as_float(u.y & 0xffff0000u);
                fu[r][i] = ((const uint2*)(ff + row * 1024))[i * 64 + lane];
            }
        }
    }
#pragma unroll
    for (int r = 0; r < NR; ++r) {
        const size_t row = (size_t)(row0 + r);
        if (mode) {
            float fv[4][4]; float ss = 0.f;
#pragma unroll
            for (int i = 0; i < 4; ++i) {
                const uint2 u = fu[r][i];
                fv[i][0] = __uint_as_float(u.x << 16); fv[i][1] = __uint_as_float(u.x & 0xffff0000u);
                fv[i][2] = __uint_as_float(u.y << 16); fv[i][3] = __uint_as_float(u.y & 0xffff0000u);
                ss += fv[i][0] * fv[i][0] + fv[i][1] * fv[i][1] + fv[i][2] * fv[i][2] + fv[i][3] * fv[i][3];
            }
            ss = wave_sum(ss);
            const float sc = rsqrtf(ss * (1.0f / 1024.0f) + 1e-6f);
#pragma unroll
            for (int i = 0; i < 4; ++i) {
                const float4 g = ((const float4*)gain)[i * 64 + lane];
                xv[r][i].x += fv[i][0] * sc * g.x; xv[r][i].y += fv[i][1] * sc * g.y; xv[r][i].z += fv[i][2] * sc * g.z; xv[r][i].w += fv[i][3] * sc * g.w;
            }
        }
        if (fin) {
#pragma unroll
            for (int i = 0; i < 4; ++i) ((float4*)(cx.out + row * 1024))[i * 64 + lane] = xv[r][i];
        } else {
            float s2 = 0.f;
#pragma unroll
            for (int i = 0; i < 4; ++i) s2 += xv[r][i].x * xv[r][i].x + xv[r][i].y * xv[r][i].y + xv[r][i].z * xv[r][i].z + xv[r][i].w * xv[r][i].w;
            s2 = wave_sum(s2);
            if (lane == 0) rinv[row] = rsqrtf(s2 * (1.0f / 1024.0f) + 1e-6f);
#pragma unroll
            for (int i = 0; i < 4; ++i) {
                uint2 w; w.x = pk_bf16(xv[r][i].x, xv[r][i].y); w.y = pk_bf16(xv[r][i].z, xv[r][i].w);
                ((uint2*)(xb + row * 1024))[i * 64 + lane] = w;
            }
        }
    }
}
__device__ __forceinline__ void phase_row(const Params& p, const Ctx& cx, int mode, int l, bool dry = false) {
    const int wave = cx.tid >> 6;
    for (int row = (cx.bid * 8 + wave) * 4; row < T; row += cx.nb * 8 * 4) rows_do<4>(p, cx, mode, l, row);
}

__device__ __forceinline__ void phase_convw(const Params& p, const Ctx& cx, int l, int tl0 = 0, int tl1 = 3136) {
    extern __shared__ __attribute__((aligned(16))) bf16_t shm[];
    float* tile = (float*)shm;
    const int tid = cx.tid;
    char* wb_ = wbase(cx, l);
    for (int tl = tl0 + cx.bid; tl < tl1; tl += cx.nb) {
        const float* W; const float* g; bf16_t* Wt; int K, N, nNt, loc;
        if (tl < 832) { W = p.in[5 + cx.z] + (size_t)l * 1024 * 3200; g = p.in[1 + cx.z] + l * 1024; Wt = (bf16_t*)(wb_ + OFF_WIN); K = 1024; N = 3200; nNt = 52; loc = tl; }
        else if (tl < 1088) { W = p.in[6 + cx.z] + (size_t)l * 1024 * 1024; g = nullptr; Wt = (bf16_t*)(wb_ + OFF_WOUT); K = 1024; N = 1024; nNt = 16; loc = tl - 832; }
        else if (tl < 2112) { W = p.in[28 + cx.z] + (size_t)l * 1024 * 4096; g = p.in[3 + cx.z] + l * 1024; Wt = (bf16_t*)(wb_ + OFF_W1); K = 1024; N = 4096; nNt = 64; loc = tl - 1088; }
        else { W = p.in[29 + cx.z] + (size_t)l * 4096 * 1024; g = nullptr; Wt = (bf16_t*)(wb_ + OFF_W2); K = 4096; N = 1024; nNt = 16; loc = tl - 2112; }
        const int k0 = (loc / nNt) * 64, n0 = (loc % nNt) * 64;
#pragma unroll
        for (int i = 0; i < 8; ++i) {
            const int k = i * 8 + (tid >> 6), n = tid & 63;
            float v = 0.f;
            if (n0 + n < N) { v = W[(size_t)(k0 + k) * N + n0 + n]; if (g) v *= g[k0 + k]; }
            tile[k * 65 + n] = v;
        }
        __syncthreads();
#pragma unroll
        for (int i = 0; i < 4; ++i) {
            const int n = i * 16 + (tid >> 5), k = (tid & 31) * 2;
            *(unsigned*)(Wt + (size_t)(n0 + n) * K + k0 + k) = pk_bf16(tile[k * 65 + n], tile[(k + 1) * 65 + n]);
        }
        __syncthreads();
    }
}

__device__ __forceinline__ void phase_lb(const Params& p, const Ctx& cx) {
    if (cx.bid == 0 && cx.tid < 256) {
        const int c = cx.tid;
        float v[4], mx = -1e30f;
        for (int l = 0; l < 4; ++l) { v[l] = p.in[8 + cx.z][l * 256 + c]; mx = fmaxf(mx, v[l]); }
        float s = 0.f;
        for (int l = 0; l < 4; ++l) { v[l] = expf(v[l] - mx); s += v[l]; }
        float* lb = (float*)(cx.ws + OFF_SM + SM_LB);
        float cum = 0.f;
        for (int l = 0; l < 4; ++l) { if (l > 0) cum += v[l] / s; lb[l * 256 + c] = fmaxf(cum, 0.f); }
    }
}

__device__ __forceinline__ void attn_phase(const Params& p, const Ctx& cx, int l) {
    extern __shared__ __attribute__((aligned(16))) bf16_t shm[];
    bf16_t* vT = shm;
    float* sb = (float*)((char*)shm + 69632);
    const bf16_t* proj = (const bf16_t*)(cx.ws + OFF_PH);
    bf16_t* mix = (bf16_t*)(cx.ws + OFF_MIX);
    const int tid = cx.tid, w = tid >> 6, lane = tid & 63, fr = lane & 15, fq = lane >> 4;
    const int h = w >> 1, qh = w & 1;
    for (int i = tid; i < 2052; i += 512) sb[i] = p.in[7 + cx.z][l * 2052 + i];
    const float* sbh = sb + h * 513;
    for (int item = cx.bid; item < 512; item += cx.nb) {
        const int b = item >> 7, c = item & 127;
        const size_t tq = (size_t)b * SEQ + c * 64;
        bf16x8 Qf[2][2];
#pragma unroll
        for (int qt = 0; qt < 2; ++qt)
#pragma unroll
            for (int ks = 0; ks < 2; ++ks)
                Qf[qt][ks] = *(const bf16x8*)(proj + (tq + qh * 32 + qt * 16 + fr) * DIN + h * 64 + ks * 32 + fq * 8);
        f32x4 O[4][2];
#pragma unroll
        for (int dt = 0; dt < 4; ++dt) { O[dt][0] = (f32x4){0.f, 0.f, 0.f, 0.f}; O[dt][1] = (f32x4){0.f, 0.f, 0.f, 0.f}; }
        float mrun[2] = {-1e30f, -1e30f}, lsum[2] = {0.f, 0.f};
        const int j0 = (8 - c) > 0 ? (8 - c) : 0;
        auto stage = [&](int j, int buf) {
            const size_t tk = (size_t)b * SEQ + (size_t)(c - 8 + j) * 64;
#pragma unroll
            for (int i = 0; i < 4; ++i) {
                const int idx = i * 512 + tid, key = idx & 63, cgp = idx >> 6;
                const bf16x8 v = *(const bf16x8*)(proj + (tk + key) * DIN + 512 + cgp * 8);
                const int hd = cgp >> 3, d0 = (cgp & 7) * 8;
#pragma unroll
                for (int jj = 0; jj < 8; ++jj) vT[((buf * 4 + hd) * 64 + d0 + jj) * 68 + key] = (bf16_t)v[jj];
            }
        };
        __syncthreads();
        stage(j0, 0);
        bf16x8 Kc[4][2];
        {
            const size_t tk0 = (size_t)b * SEQ + (size_t)(c - 8 + j0) * 64;
#pragma unroll
            for (int kt = 0; kt < 4; ++kt) {
                Kc[kt][0] = *(const bf16x8*)(proj + (tk0 + kt * 16 + fr) * DIN + 256 + h * 64 + fq * 8);
                Kc[kt][1] = *(const bf16x8*)(proj + (tk0 + kt * 16 + fr) * DIN + 256 + h * 64 + 32 + fq * 8);
            }
        }
        __syncthreads();
        for (int j = j0; j <= 8; ++j) {
            const int cur = (j - j0) & 1;
            if (j < 8) stage(j + 1, cur ^ 1);
            const size_t tk = (size_t)b * SEQ + (size_t)(c - 8 + j) * 64;
            f32x4 S[4][2];
#pragma unroll
            for (int kt = 0; kt < 4; ++kt) {
#pragma unroll
                for (int qt = 0; qt < 2; ++qt) {
                    f32x4 a = (f32x4){0.f, 0.f, 0.f, 0.f};
                    a = __builtin_amdgcn_mfma_f32_16x16x32_bf16(Kc[kt][0], Qf[qt][0], a, 0, 0, 0);
                    a = __builtin_amdgcn_mfma_f32_16x16x32_bf16(Kc[kt][1], Qf[qt][1], a, 0, 0, 0);
                    S[kt][qt] = a;
                }
            }
            if (j < 8) {
#pragma unroll
                for (int kt = 0; kt < 4; ++kt) {
                    Kc[kt][0] = *(const bf16x8*)(proj + (tk + 64 + kt * 16 + fr) * DIN + 256 + h * 64 + fq * 8);
                    Kc[kt][1] = *(const bf16x8*)(proj + (tk + 64 + kt * 16 + fr) * DIN + 256 + h * 64 + 32 + fq * 8);
                }
            }
            const int relbase = (j - 8) * 64 - (qh * 32 + fr) + fq * 4;
#pragma unroll
            for (int qt = 0; qt < 2; ++qt) {
                float mx = -1e30f;
#pragma unroll
                for (int kt = 0; kt < 4; ++kt)
#pragma unroll
                    for (int jj = 0; jj < 4; ++jj) {
                        int rel = relbase + kt * 16 + jj - qt * 16;
                        rel = rel < -256 ? -256 : (rel > 256 ? 256 : rel);
                        const float s = S[kt][qt][jj] * 0.125f + sbh[rel + 256];
                        S[kt][qt][jj] = s; mx = fmaxf(mx, s);
                    }
                mx = fmaxf(mx, shx(mx, lane, 16)); mx = fmaxf(mx, shx(mx, lane, 32));
                const float mn = fmaxf(mrun[qt], mx);
                const float alpha = __expf(mrun[qt] - mn);
                mrun[qt] = mn;
                float ps = 0.f;
#pragma unroll
                for (int kt = 0; kt < 4; ++kt)
#pragma unroll
                    for (int jj = 0; jj < 4; ++jj) { const float pv = __expf(S[kt][qt][jj] - mn); S[kt][qt][jj] = pv; ps += pv; }
                lsum[qt] = lsum[qt] * alpha + ps;
#pragma unroll
                for (int dt = 0; dt < 4; ++dt) O[dt][qt] *= alpha;
            }
#pragma unroll
            for (int gk = 0; gk < 2; ++gk) {
                bf16x8 Pf[2];
#pragma unroll
                for (int qt = 0; qt < 2; ++qt) {
                    union { unsigned u[4]; bf16x8 v; } cv;
                    cv.u[0] = pk_bf16(S[2 * gk][qt][0], S[2 * gk][qt][1]); cv.u[1] = pk_bf16(S[2 * gk][qt][2], S[2 * gk][qt][3]);
                    cv.u[2] = pk_bf16(S[2 * gk + 1][qt][0], S[2 * gk + 1][qt][1]); cv.u[3] = pk_bf16(S[2 * gk + 1][qt][2], S[2 * gk + 1][qt][3]);
                    Pf[qt] = cv.v;
                }
#pragma unroll
                for (int dt = 0; dt < 4; ++dt) {
                    const bf16_t* vp = vT + ((cur * 4 + h) * 64 + dt * 16 + fr) * 68 + gk * 32 + fq * 4;
                    union { uint2 u[2]; bf16x8 v; } vv;
                    vv.u[0] = *(const uint2*)vp; vv.u[1] = *(const uint2*)(vp + 16);
                    O[dt][0] = __builtin_amdgcn_mfma_f32_16x16x32_bf16(vv.v, Pf[0], O[dt][0], 0, 0, 0);
                    O[dt][1] = __builtin_amdgcn_mfma_f32_16x16x32_bf16(vv.v, Pf[1], O[dt][1], 0, 0, 0);
                }
            }
            __syncthreads();
        }
#pragma unroll
        for (int qt = 0; qt < 2; ++qt) {
            float lt = lsum[qt];
            lt += shx(lt, lane, 16); lt += shx(lt, lane, 32);
            const float inv = 1.0f / lt;
            bf16_t* orow = mix + (tq + qh * 32 + qt * 16 + fr) * 1024 + h * 64 + fq * 4;
#pragma unroll
            for (int dt = 0; dt < 4; ++dt) {
                uint2 wv; wv.x = pk_bf16(O[dt][qt][0] * inv, O[dt][qt][1] * inv); wv.y = pk_bf16(O[dt][qt][2] * inv, O[dt][qt][3] * inv);
                *(uint2*)(orow + dt * 16) = wv;
            }
        }
    }
    __syncthreads();
}

__device__ __forceinline__ void hgrn_m1(const Params& p, const Ctx& cx, int l) {
    extern __shared__ __attribute__((aligned(16))) bf16_t shm[];
    const int wave = cx.tid >> 6, lane = cx.tid & 63;
    float* sl = (float*)shm + wave * 3072;
    const bf16_t* proj = (const bf16_t*)(cx.ws + OFF_PH);
    bf16_t* mix = (bf16_t*)(cx.ws + OFF_MIX);
    float* U = (float*)(cx.ws + OFF_HU);
    float* dec = (float*)(cx.ws + OFF_SM + SM_DEC);
    const float* lbp = (const float*)(cx.ws + OFF_SM + SM_LB) + l * 256;
    for (int it = cx.bid * 8 + wave; it < 2048; it += cx.nb * 8) {
        const int bh = it >> 7, c = it & 127, b = bh >> 2, h = bh & 3;
        const size_t t0 = (size_t)b * SEQ + c * 64;
        const float lb = lbp[h * 64 + lane];
        f32x2 L[32];
#pragma unroll
        for (int k = 0; k < 32; ++k) L[k] = (f32x2){0.f, 0.f};
        float D = 1.f;
        for (int sub = 0; sub < 4; ++sub) {
            bf16_t qraw[16], fraw[16], iraw[16];
#pragma unroll
            for (int tt = 0; tt < 16; ++tt) {
                const bf16_t* row = proj + (t0 + sub * 16 + tt) * DIN + 768 + h * 64 + lane;
                qraw[tt] = row[0]; fraw[tt] = row[256]; iraw[tt] = row[512];
            }
#pragma unroll
            for (int tt = 0; tt < 16; ++tt) {
                const float qr = bf2f(qraw[tt]), fr_ = bf2f(fraw[tt]);
                const float e = __expf(-fr_), sg = 1.0f / (1.0f + e);
                const float f = lb + (1.f - lb) * sg, key = (1.f - lb) * e * sg;
                D *= f;
                sl[tt * 192 + lane] = f; sl[tt * 192 + 64 + lane] = key; sl[tt * 192 + 128 + lane] = qr * sigm(qr);
            }
            __builtin_amdgcn_fence(__ATOMIC_RELEASE, "wavefront");
            __builtin_amdgcn_wave_barrier();
#pragma unroll
            for (int tt = 0; tt < 16; ++tt) {
                const size_t t = t0 + sub * 16 + tt;
                const float iv = bf2f(iraw[tt]);
                const f32x2 iv2 = (f32x2){iv, iv};
                f32x2 o2 = (f32x2){0.f, 0.f};
                const float* sr = sl + tt * 192;
#pragma unroll
                for (int j = 0; j < 16; ++j) {
                    const f32x4 f4 = *(const f32x4*)(sr + 4 * j), k4 = *(const f32x4*)(sr + 64 + 4 * j), q4 = *(const f32x4*)(sr + 128 + 4 * j);
                    L[2 * j] = (f32x2){f4[0], f4[1]} * L[2 * j] + (f32x2){k4[0], k4[1]} * iv2;
                    o2 += (f32x2){q4[0], q4[1]} * L[2 * j];
                    L[2 * j + 1] = (f32x2){f4[2], f4[3]} * L[2 * j + 1] + (f32x2){k4[2], k4[3]} * iv2;
                    o2 += (f32x2){q4[2], q4[3]} * L[2 * j + 1];
                }
                mix[t * 1024 + 256 + h * 64 + lane] = f2bf(o2[0] + o2[1]);
            }
            __builtin_amdgcn_fence(__ATOMIC_RELEASE, "wavefront");
            __builtin_amdgcn_wave_barrier();
        }
#pragma unroll
        for (int k = 0; k < 32; ++k) { U[(size_t)it * 4096 + (2 * k) * 64 + lane] = L[k][0]; U[(size_t)it * 4096 + (2 * k + 1) * 64 + lane] = L[k][1]; }
        dec[it * 64 + lane] = D;
    }
    __syncthreads();
}

__device__ __forceinline__ void hgrn_m3(const Params& p, const Ctx& cx, int l, bool dry = false) {
    extern __shared__ __attribute__((aligned(16))) bf16_t shm[];
    const int wave = cx.tid >> 6, lane = cx.tid & 63;
    float* sl = (float*)shm + wave * 1024;
    const bf16_t* proj = (const bf16_t*)(cx.ws + OFF_PH);
    bf16_t* mix = (bf16_t*)(cx.ws + OFF_MIX);
    const float* U = (const float*)(cx.ws + OFF_HU);
    const float* lbp = (const float*)(cx.ws + OFF_SM + SM_LB) + l * 256;
    for (int it = cx.bid * 8 + wave; it < 2048; it += cx.nb * 8) {
        const int bh = it >> 7, c = it & 127, b = bh >> 2, h = bh & 3;
        const size_t t0 = (size_t)b * SEQ + c * 64;
        const float lb = lbp[h * 64 + lane];
        const float hn = p.in[9 + cx.z][l * 256 + h * 64 + lane];
        float S[64];
#pragma unroll
        for (int k = 0; k < 64; ++k) S[k] = U[(size_t)it * 4096 + k * 64 + lane];
        float G = 1.f;
        for (int sub = 0; sub < 4; ++sub) {
            bf16_t qraw[16], fraw[16], graw[16], oraw[16];
#pragma unroll
            for (int tt = 0; tt < 16; ++tt) {
                const size_t t = t0 + sub * 16 + tt;
                const bf16_t* row = proj + t * DIN + 768 + h * 64 + lane;
                qraw[tt] = row[0]; fraw[tt] = row[256]; graw[tt] = row[768];
                oraw[tt] = mix[t * 1024 + 256 + h * 64 + lane];
            }
#pragma unroll
            for (int tt = 0; tt < 16; ++tt) {
                const float qr = bf2f(qraw[tt]), fr_ = bf2f(fraw[tt]);
                const float f = lb + (1.f - lb) * sigm(fr_);
                G *= f;
                sl[tt * 64 + lane] = qr * sigm(qr) * G;
            }
            __builtin_amdgcn_fence(__ATOMIC_RELEASE, "wavefront");
            __builtin_amdgcn_wave_barrier();
#pragma unroll
            for (int tt = 0; tt < 16; ++tt) {
                const size_t t = t0 + sub * 16 + tt;
                const float* sr = sl + tt * 64;
                float o = 0.f;
#pragma unroll
                for (int j = 0; j < 16; ++j) {
                    const f32x4 q4 = *(const f32x4*)(sr + 4 * j);
                    o += q4[0] * S[4 * j] + q4[1] * S[4 * j + 1] + q4[2] * S[4 * j + 2] + q4[3] * S[4 * j + 3];
                }
                const size_t idx = t * 1024 + 256 + h * 64 + lane;
                o += bf2f(oraw[tt]);
                const float ms = wave_sum(o * o) * (1.0f / 64.0f);
                const float gr = bf2f(graw[tt]);
                if (!dry || ms == 1.2345e33f) mix[idx] = f2bf(o * rsqrtf(ms + 1e-6f) * hn * gr * sigm(gr));
            }
            __builtin_amdgcn_fence(__ATOMIC_RELEASE, "wavefront");
            __builtin_amdgcn_wave_barrier();
        }
    }
    __syncthreads();
}

__device__ __forceinline__ void rwkv_pre(const Params& p, const Ctx& cx, int l) {
    extern __shared__ __attribute__((aligned(16))) bf16_t shm[];
    float* wl = (float*)shm + (cx.tid >> 6) * 64;
    const int w = cx.tid >> 6, lane = cx.tid & 63, h = w & 3, th = w >> 2, c = h * 64 + lane;
    const bf16_t* proj = (const bf16_t*)(cx.ws + OFF_PH);
    bf16_t* RW = (bf16_t*)(cx.ws + OFF_RW);
    float w2c[32], a2c[32];
#pragma unroll
    for (int j = 0; j < 32; ++j) { w2c[j] = p.in[12 + cx.z][(l * 32 + j) * 256 + c]; a2c[j] = p.in[14 + cx.z][(l * 32 + j) * 256 + c]; }
    const float w0 = p.in[11 + cx.z][l * 256 + c], a0 = p.in[13 + cx.z][l * 256 + c], kkc = p.in[16 + cx.z][l * 256 + c], kac = p.in[17 + cx.z][l * 256 + c];
    const float* mu = p.in[10 + cx.z] + l * 896;
    const float mu_r = mu[c], mu_k = mu[256 + c], mu_v = mu[512 + c], mu_lo = mu[768 + lane];
    for (int tile = cx.bid; tile < 1024; tile += cx.nb) {
        const int tbase = tile * 32 + th * 16;
        bf16_t cr[17], ck[17], cv[17], cl[17];
#pragma unroll
        for (int i = 0; i < 17; ++i) {
            const bf16_t* rp = proj + (size_t)(tbase + i - 1) * DIN + 1792;
            if (i == 0 && (tbase & (SEQ - 1)) == 0) { cr[i] = 0; ck[i] = 0; cv[i] = 0; cl[i] = 0; }
            else { cr[i] = rp[c]; ck[i] = rp[256 + c]; cv[i] = rp[512 + c]; cl[i] = rp[768 + lane]; }
        }
        float Dc = 1.0f;
#pragma unroll
        for (int i = 0; i < 16; ++i) {
            const int t = tbase + i, s = t & (SEQ - 1), b = t >> 13;
            float x0, x1;
            x0 = bf2f(cr[i + 1]); x1 = bf2f(cr[i]); const float r = x0 + mu_r * (x1 - x0);
            x0 = bf2f(ck[i + 1]); x1 = bf2f(ck[i]); const float k = x0 + mu_k * (x1 - x0);
            x0 = bf2f(cv[i + 1]); x1 = bf2f(cv[i]); const float v = x0 + mu_v * (x1 - x0);
            x0 = bf2f(cl[i + 1]); x1 = bf2f(cl[i]); float lo = x0 + mu_lo * (x1 - x0);
            if (lane < 32) lo = 2.0f * sigm(2.0f * lo) - 1.0f;
            f32x2 ws2 = (f32x2){w0, 0.f}, as2 = (f32x2){a0, 0.f};
            wl[lane] = lo;
            __builtin_amdgcn_fence(__ATOMIC_RELEASE, "wavefront");
            __builtin_amdgcn_wave_barrier();
#pragma unroll
            for (int j4 = 0; j4 < 8; ++j4) {
                const f32x4 a4 = *(const f32x4*)(wl + 4 * j4), b4 = *(const f32x4*)(wl + 32 + 4 * j4);
                ws2 += (f32x2){a4[0], a4[1]} * (f32x2){w2c[4 * j4], w2c[4 * j4 + 1]}; ws2 += (f32x2){a4[2], a4[3]} * (f32x2){w2c[4 * j4 + 2], w2c[4 * j4 + 3]};
                as2 += (f32x2){b4[0], b4[1]} * (f32x2){a2c[4 * j4], a2c[4 * j4 + 1]}; as2 += (f32x2){b4[2], b4[3]} * (f32x2){a2c[4 * j4 + 2], a2c[4 * j4 + 3]};
            }
            __builtin_amdgcn_wave_barrier();
            const float wsum = ws2[0] + ws2[1], asum = as2[0] + as2[1];
            const float nx = -wsum;
            const float sp = fmaxf(nx, 0.f) + __logf(1.0f + __expf(-fabsf(nx)));
            const float wpre = -sp - 0.5f;
            const float omw = 1.0f - __expf(-__expf(wpre));
            const float a = sigm(asum);
            const float kkr = k * kkc;
            const float ssq = wave_sum(kkr * kkr);
            const float kk = kkr * fminf(__builtin_amdgcn_rsqf(ssq), 1e12f);
            const float kmod = k * (1.f + (a - 1.f) * kac);
            bf16_t* o = RW + (((size_t)(b * 4 + h) * SEQ + s) * 6) * 64 + lane;
            const float Dp = Dc;
            Dc *= (1.0f - omw);
            const float iD = __builtin_amdgcn_rcpf(Dc);
            o[0] = f2bf(r * Dc); o[64] = f2bf(Dc > 0.5f ? (Dc - 1.0f) : Dc);     o[128] = f2bf(kmod * iD); o[192] = f2bf(-kk * Dp); o[256] = f2bf(kk * a * iD); o[320] = f2bf(v);
        }
    }
    __syncthreads();
}

__device__ __forceinline__ void rwkv_post(const Params& p, const Ctx& cx, int l, bool dry = false) {
    extern __shared__ __attribute__((aligned(16))) bf16_t shm[];
    float* wl = (float*)shm + (cx.tid >> 6) * 64;
    const int w = cx.tid >> 6, lane = cx.tid & 63, h = w & 3, th = w >> 2, c = h * 64 + lane;
    const bf16_t* proj = (const bf16_t*)(cx.ws + OFF_PH);
    const bf16_t* RW = (const bf16_t*)(cx.ws + OFF_RW);
    bf16_t* mix = (bf16_t*)(cx.ws + OFF_MIX);
    float g2c[64];
#pragma unroll
    for (int j = 0; j < 64; ++j) g2c[j] = p.in[15 + cx.z][(l * 64 + j) * 256 + c];
    const float lnw = p.in[19 + cx.z][l * 256 + c], lnb = p.in[20 + cx.z][l * 256 + c], rk = p.in[18 + cx.z][l * 256 + c];
    const float mu_g = p.in[10 + cx.z][l * 896 + 832 + lane];
    for (int tile = cx.bid; tile < 1024; tile += cx.nb) {
        const int tbase = tile * 32 + th * 16;
        bf16_t cg_[17], yr[16], ar[16], ak[16], av[16];
#pragma unroll
        for (int i = 0; i < 17; ++i) {
            if (i == 0 && (tbase & (SEQ - 1)) == 0) cg_[i] = 0;
            else cg_[i] = proj[(size_t)(tbase + i - 1) * DIN + 1792 + 832 + lane];
        }
#pragma unroll
        for (int i = 0; i < 16; ++i) {
            const int t = tbase + i, s = t & (SEQ - 1), b = t >> 13;
            yr[i] = mix[(size_t)t * 1024 + 512 + c];
            const bf16_t* a = RW + (((size_t)(b * 4 + h) * SEQ + s) * 6) * 64 + lane;
            ar[i] = a[0]; ak[i] = a[128]; av[i] = a[320];
        }
#pragma unroll
        for (int i = 0; i < 16; ++i) {
            const int t = tbase + i;
            const float x0 = bf2f(cg_[i + 1]), x1 = bf2f(cg_[i]);
            const float gl = sigm(x0 + mu_g * (x1 - x0));
            f32x2 g2 = (f32x2){0.f, 0.f};
            wl[lane] = gl;
            __builtin_amdgcn_fence(__ATOMIC_RELEASE, "wavefront");
            __builtin_amdgcn_wave_barrier();
#pragma unroll
            for (int j4 = 0; j4 < 16; ++j4) {
                const f32x4 a4 = *(const f32x4*)(wl + 4 * j4);
                g2 += (f32x2){a4[0], a4[1]} * (f32x2){g2c[4 * j4], g2c[4 * j4 + 1]}; g2 += (f32x2){a4[2], a4[3]} * (f32x2){g2c[4 * j4 + 2], g2c[4 * j4 + 3]};
            }
            __builtin_amdgcn_wave_barrier();
            const float g = g2[0] + g2[1];
            const size_t idx = (size_t)t * 1024 + 512 + c;
            const float y = bf2f(yr[i]);
            const float r = bf2f(ar[i]), km = bf2f(ak[i]), v = bf2f(av[i]);
            float s1 = y, s2 = y * y, s3 = r * km * rk;
            wave_sum3(s1, s2, s3);
            const float mean = s1 * (1.0f / 64.0f);
            const float var = fmaxf(s2 * (1.0f / 64.0f) - mean * mean, 0.f);
            const float yn = (y - mean) * rsqrtf(var + 64e-5f) * lnw + lnb;
            const float bonus = s3 * v;
            if (!dry || g == 1.2345e33f) mix[idx] = f2bf((yn + bonus) * g);
        }
    }
    __syncthreads();
}

__device__ __forceinline__ void rwkv_scan(const Params& p, const Ctx& cx, int l, int unit) {
    extern __shared__ __attribute__((aligned(16))) bf16_t shm[];
    float* buf = (float*)shm;
    float* ybuf = (float*)shm + 2 * 12288;
    const int tid = cx.tid, lane = tid & 63, wv = tid >> 6;
    const bool scan = tid < 256;
    const int lt = tid - 256;
    const bf16_t* RW = (const bf16_t*)(cx.ws + OFF_RW);
    bf16_t* mix = (bf16_t*)(cx.ws + OFF_MIX);
    const int chain = unit >> 2, qr = unit & 3, b = chain >> 2, h = chain & 3;
    const unsigned* src0 = (const unsigned*)(RW + (size_t)chain * SEQ * 384);
    uint2 pre[24];
    const int grp = lt >> 7, l2 = lt & 127;
    if (!scan) {
        const uint2* s2 = (const uint2*)src0;
        if (grp == 1) {
#pragma unroll
            for (int j = 0; j < 24; ++j) pre[j] = s2[l2 + 128 * j];
#pragma unroll
            for (int j = 0; j < 24; ++j) { const uint2 u = pre[j]; ((float4*)buf)[l2 + 128 * j] = make_float4(__uint_as_float(u.x << 16), __uint_as_float(u.x & 0xffff0000u), __uint_as_float(u.y << 16), __uint_as_float(u.y & 0xffff0000u)); }
#pragma unroll
            for (int j = 0; j < 24; ++j) pre[j] = s2[3072 + l2 + 128 * j];
        } else {
#pragma unroll
            for (int j = 0; j < 24; ++j) pre[j] = s2[2 * 3072 + l2 + 128 * j];
        }
    }
    __syncthreads();
    const int g4 = lane >> 4, q = lane & 15, rloc = wv * 4 + g4, row = qr * 16 + rloc;
    f32x2 s01 = (f32x2){0.f, 0.f}, s23 = (f32x2){0.f, 0.f};
    for (int nb = 0; nb < 256; ++nb) {
        const int cur = nb & 1;
        if (scan) {
            const float* bb = buf + cur * 12288;
            float ysel0 = 0.f, ysel1 = 0.f, yp = 0.f;
            f32x4 r4 = *(const f32x4*)(bb + 4 * q), w4 = *(const f32x4*)(bb + 64 + 4 * q), k4 = *(const f32x4*)(bb + 128 + 4 * q);
            f32x4 kk4 = *(const f32x4*)(bb + 192 + 4 * q), ka4 = *(const f32x4*)(bb + 256 + 4 * q);
            float v = bb[320 + row];
            f32x4 nr4 = *(const f32x4*)(bb + 384 + 4 * q), nw4 = *(const f32x4*)(bb + 384 + 64 + 4 * q), nk4 = *(const f32x4*)(bb + 384 + 128 + 4 * q);
            f32x4 nkk4 = *(const f32x4*)(bb + 384 + 192 + 4 * q), nka4 = *(const f32x4*)(bb + 384 + 256 + 4 * q);
            float nv = bb[384 + 320 + row];
#pragma unroll
            for (int i = 0; i < 32; ++i) {
                f32x4 mr4 = nr4, mw4 = nw4, mk4 = nk4, mkk4 = nkk4, mka4 = nka4; float mv = nv;
                if (i < 30) {
                    const float* tb = bb + (i + 2) * 384;
                    mr4 = *(const f32x4*)(tb + 4 * q); mw4 = *(const f32x4*)(tb + 64 + 4 * q); mk4 = *(const f32x4*)(tb + 128 + 4 * q);
                    mkk4 = *(const f32x4*)(tb + 192 + 4 * q); mka4 = *(const f32x4*)(tb + 256 + 4 * q); mv = tb[320 + row];
                }
                const f32x2 d2 = s01 * (f32x2){kk4[0], kk4[1]} + s23 * (f32x2){kk4[2], kk4[3]};
                float dA = d2[0] + d2[1];
                float yB = yp;
                f32x2 t01, t23;
                dA += dpp_f<0xB1>(dA);  yB += dpp_f<0xB1>(yB);  t01 = s01 + (f32x2){v, v} * (f32x2){k4[0], k4[1]};
                dA += dpp_f<0x4E>(dA);  yB += dpp_f<0x4E>(yB);  t23 = s23 + (f32x2){v, v} * (f32x2){k4[2], k4[3]};
                dA += dpp_f<0x141>(dA); yB += dpp_f<0x141>(yB);
                dA += dpp_f<0x140>(dA); yB += dpp_f<0x140>(yB);
                if (i > 0) { if (i <= 16) ysel0 = (q == i - 1) ? yB : ysel0; else ysel1 = (q == i - 17) ? yB : ysel1; }
                s01 = t01 + (f32x2){dA, dA} * (f32x2){ka4[0], ka4[1]};
                s23 = t23 + (f32x2){dA, dA} * (f32x2){ka4[2], ka4[3]};
                const f32x2 y2 = s01 * (f32x2){r4[0], r4[1]} + s23 * (f32x2){r4[2], r4[3]};
                yp = y2[0] + y2[1];
                if ((i & 15) == 15) {
                    const float d0 = w4[0] < 0.f ? 1.0f + w4[0] : w4[0], d1 = w4[1] < 0.f ? 1.0f + w4[1] : w4[1];
                    const float d2_ = w4[2] < 0.f ? 1.0f + w4[2] : w4[2], d3 = w4[3] < 0.f ? 1.0f + w4[3] : w4[3];
                    s01 = s01 * (f32x2){d0, d1}; s23 = s23 * (f32x2){d2_, d3};
                }
                r4 = nr4; w4 = nw4; k4 = nk4; kk4 = nkk4; ka4 = nka4; v = nv;
                nr4 = mr4; nw4 = mw4; nk4 = mk4; nkk4 = mkk4; nka4 = mka4; nv = mv;
            }
            { const float yl = row16_sum(yp); ysel1 = (q == 15) ? yl : ysel1; }
            ybuf[cur * 512 + q * 16 + rloc] = ysel0;
            ybuf[cur * 512 + (16 + q) * 16 + rloc] = ysel1;
        } else {
            if (grp == ((nb + 1) & 1)) {
                if (nb + 1 < 256) {
                    float4* dst = (float4*)(buf + (cur ^ 1) * 12288);
#pragma unroll
                    for (int j = 0; j < 24; ++j) { const uint2 u = pre[j]; dst[l2 + 128 * j] = make_float4(__uint_as_float(u.x << 16), __uint_as_float(u.x & 0xffff0000u), __uint_as_float(u.y << 16), __uint_as_float(u.y & 0xffff0000u)); }
                }
                if (nb + 3 < 256) {
                    const uint2* src = (const uint2*)src0 + (size_t)(nb + 3) * 3072;
#pragma unroll
                    for (int j = 0; j < 24; ++j) pre[j] = src[l2 + 128 * j];
                }
            }
            if (nb > 0 && lt < 128) {
                const f32x4 yv = *(const f32x4*)(ybuf + (cur ^ 1) * 512 + lt * 4);
                uint2 wv2; wv2.x = pk_bf16(yv[0], yv[1]); wv2.y = pk_bf16(yv[2], yv[3]);
                *(uint2*)(mix + ((size_t)b * SEQ + (nb - 1) * 32 + (lt >> 2)) * 1024 + 512 + h * 64 + qr * 16 + (lt & 3) * 4) = wv2;
            }
        }
        __syncthreads();
    }
    if (!scan && lt < 128) {
        const f32x4 yv = *(const f32x4*)(ybuf + 512 + lt * 4);
        uint2 wv2; wv2.x = pk_bf16(yv[0], yv[1]); wv2.y = pk_bf16(yv[2], yv[3]);
        *(uint2*)(mix + ((size_t)b * SEQ + 255 * 32 + (lt >> 2)) * 1024 + 512 + h * 64 + qr * 16 + (lt & 3) * 4) = wv2;
    }
    __syncthreads();
}

__device__ __forceinline__ void lru_carry_wave(const Ctx& cx, int chain) {
    const float* hend = (const float*)(cx.ws + OFF_SM + SM_HEND);
    const float* ptot = (const float*)(cx.ws + OFF_SM + SM_PTOT);
    float* carry = (float*)(cx.ws + OFF_SM + SM_CARRY);
    const int lane = cx.tid & 63, bb = chain >> 8, e = chain & 255;
    float P[4], H[4];
#pragma unroll
    for (int k = 0; k < 4; ++k) { const int ix = (bb * 256 + lane * 4 + k) * 256 + e; P[k] = ptot[ix]; H[k] = hend[ix]; }
    float A = 1.f, B = 0.f;
#pragma unroll
    for (int k = 0; k < 4; ++k) { B = P[k] * B + H[k]; A = P[k] * A; }
#pragma unroll
    for (int d = 1; d < 64; d <<= 1) {
        const float Ap = __int_as_float(__builtin_amdgcn_ds_bpermute(((lane - d) & 63) << 2, __float_as_int(A)));
        const float Bp = __int_as_float(__builtin_amdgcn_ds_bpermute(((lane - d) & 63) << 2, __float_as_int(B)));
        if (lane >= d) { B = A * Bp + B; A = A * Ap; }
    }
    float x = __int_as_float(__builtin_amdgcn_ds_bpermute(((lane - 1) & 63) << 2, __float_as_int(B)));
    if (lane == 0) x = 0.f;
#pragma unroll
    for (int k = 0; k < 4; ++k) { carry[(bb * 256 + lane * 4 + k) * 256 + e] = x; x = P[k] * x + H[k]; }
}

__device__ __forceinline__ void hgrn_state_scan(const Params& p, const Ctx& cx) {
    float* U = (float*)(cx.ws + OFF_HU);
    const float* dec = (const float*)(cx.ws + OFF_SM + SM_DEC);
    for (int g = cx.bid * 512 + cx.tid; g < 65536; g += cx.nb * 512) {
        const int bh = g >> 12, kv = g & 4095, k = kv >> 6;
        float run = 0.f;
        for (int c0 = 0; c0 < 128; c0 += 16) {
            float u[16], d[16];
#pragma unroll
            for (int j = 0; j < 16; ++j) { const int it = bh * 128 + c0 + j; u[j] = U[(size_t)it * 4096 + kv]; d[j] = dec[it * 64 + k]; }
#pragma unroll
            for (int j = 0; j < 16; ++j) { const int it = bh * 128 + c0 + j; U[(size_t)it * 4096 + kv] = run; run = d[j] * run + u[j]; }
        }
    }
}

__device__ __forceinline__ void lru_m1(const Params& p, const Ctx& cx, int l) {
    extern __shared__ __attribute__((aligned(16))) bf16_t shm[];
    float* conv = (float*)shm;
    const int tid = cx.tid, e = tid & 255, half = tid >> 8, n = e >> 6;
    const bf16_t* proj = (const bf16_t*)(cx.ws + OFF_PH);
    bf16_t* hl = (bf16_t*)cx.out;
    float* Pb = (float*)((char*)cx.out + 16 * MiB);
    float* hend = (float*)(cx.ws + OFF_SM + SM_HEND);
    float* ptot = (float*)(cx.ws + OFF_SM + SM_PTOT);
    float wa[64], wx[64];
#pragma unroll
    for (int d = 0; d < 64; ++d) { wa[d] = p.in[23 + cx.z][((l * 4 + n) * 64 + d) * 64 + (e & 63)]; wx[d] = p.in[25 + cx.z][((l * 4 + n) * 64 + d) * 64 + (e & 63)]; }
    const float cw0 = p.in[21 + cx.z][(l * 4 + 0) * 256 + e], cw1 = p.in[21 + cx.z][(l * 4 + 1) * 256 + e], cw2 = p.in[21 + cx.z][(l * 4 + 2) * 256 + e], cw3 = p.in[21 + cx.z][(l * 4 + 3) * 256 + e];
    const float cb = p.in[22 + cx.z][l * 256 + e], ba = p.in[24 + cx.z][l * 256 + e], bx = p.in[26 + cx.z][l * 256 + e];
    const float lam = p.in[27 + cx.z][l * 256 + e];
    const float spl = log1pf(__expf(-lam));
    for (int item = cx.bid; item < 512; item += cx.nb) {
        const int b = item >> 7, ch = item & 127;
        const int s0 = ch * 64 + half * 32;
        const size_t tb = (size_t)b * SEQ;
        __syncthreads();
        {
            float xm3 = (s0 >= 3) ? bf2f(proj[(tb + s0 - 3) * DIN + 2688 + e]) : 0.f;
            float xm2 = (s0 >= 2) ? bf2f(proj[(tb + s0 - 2) * DIN + 2688 + e]) : 0.f;
            float xm1 = (s0 >= 1) ? bf2f(proj[(tb + s0 - 1) * DIN + 2688 + e]) : 0.f;
            bf16_t xr[32];
#pragma unroll
            for (int tt = 0; tt < 32; ++tt) xr[tt] = proj[(tb + s0 + tt) * DIN + 2688 + e];
#pragma unroll
            for (int tt = 0; tt < 32; ++tt) {
                const float x0 = bf2f(xr[tt]);
                conv[(half * 32 + tt) * 256 + e] = cb + cw0 * xm3 + cw1 * xm2 + cw2 * xm1 + cw3 * x0;
                xm3 = xm2; xm2 = xm1; xm1 = x0;
            }
        }
        __syncthreads();
        float hst = 0.f, P = 1.f;
        for (int tt = 0; tt < 32; ++tt) {
            const int tl = half * 32 + tt;
            const float* cr = conv + tl * 256 + n * 64;
            float ga = ba, gx = bx;
#pragma unroll
            for (int d4 = 0; d4 < 16; ++d4) {
                const f32x4 c4 = *(const f32x4*)(cr + 4 * d4);
                ga += c4[0] * wa[4 * d4] + c4[1] * wa[4 * d4 + 1] + c4[2] * wa[4 * d4 + 2] + c4[3] * wa[4 * d4 + 3];
                gx += c4[0] * wx[4 * d4] + c4[1] * wx[4 * d4 + 1] + c4[2] * wx[4 * d4 + 2] + c4[3] * wx[4 * d4 + 3];
            }
            const float cv = conv[tl * 256 + e];
            const float la = -8.0f * sigm(ga) * spl;
            const float a = __expf(la);
            const float inp = __builtin_amdgcn_sqrtf(fmaxf(1.0f - a * a, 0.f)) * (sigm(gx) * cv);
            hst = a * hst + inp; P *= a;
            const size_t t = tb + s0 + tt;
            hl[t * 256 + e] = f2bf(hst); Pb[t * 256 + e] = P;
        }
        const int sc = ch * 2 + half;
        hend[(b * 256 + sc) * 256 + e] = hst; ptot[(b * 256 + sc) * 256 + e] = P;
    }
    __syncthreads();
}

__device__ __forceinline__ void lru_m3(const Params& p, const Ctx& cx, int l, bool dry = false) {
    const bf16_t* proj = (const bf16_t*)(cx.ws + OFF_PH);
    const bf16_t* hl = (const bf16_t*)cx.out;
    const float* Pb = (const float*)((const char*)cx.out + 16 * MiB);
    const float* carry = (const float*)(cx.ws + OFF_SM + SM_CARRY);
    bf16_t* mix = (bf16_t*)(cx.ws + OFF_MIX);
    const int stride = cx.nb * 512;
    for (int g0 = cx.bid * 512 + cx.tid; g0 < T * 64; g0 += 4 * stride) {
        uint2 hv[4], gv[4]; float4 pv[4], cv[4];
#pragma unroll
        for (int u = 0; u < 4; ++u) {
            const int g = g0 + u * stride;
            if (g < T * 64) {
                const int t = g >> 6, e4 = (g & 63) * 4, b = t >> 13, s_ = t & (SEQ - 1), sc = s_ >> 5;
                hv[u] = *(const uint2*)(hl + (size_t)t * 256 + e4);
                pv[u] = *(const float4*)(Pb + (size_t)t * 256 + e4);
                cv[u] = *(const float4*)(carry + (b * 256 + sc) * 256 + e4);
                gv[u] = *(const uint2*)(proj + (size_t)t * DIN + 2944 + e4);
            }
        }
#pragma unroll
        for (int u = 0; u < 4; ++u) {
            const int g = g0 + u * stride;
            if (g < T * 64) {
                const int t = g >> 6, e4 = (g & 63) * 4;
                float hh[4] = { __uint_as_float(hv[u].x << 16) + pv[u].x * cv[u].x, __uint_as_float(hv[u].x & 0xffff0000u) + pv[u].y * cv[u].y,
                                __uint_as_float(hv[u].y << 16) + pv[u].z * cv[u].z, __uint_as_float(hv[u].y & 0xffff0000u) + pv[u].w * cv[u].w };
                const float gg[4] = { __uint_as_float(gv[u].x << 16), __uint_as_float(gv[u].x & 0xffff0000u), __uint_as_float(gv[u].y << 16), __uint_as_float(gv[u].y & 0xffff0000u) };
#pragma unroll
                for (int j = 0; j < 4; ++j) {
                    const float x = gg[j];
                    hh[j] *= x * sigm(1.5957691216057308f * (x + 0.044715f * x * x * x));
                }
                uint2 wv; wv.x = pk_bf16(hh[0], hh[1]); wv.y = pk_bf16(hh[2], hh[3]);
                *(uint2*)(mix + (size_t)t * 1024 + 768 + e4) = wv;
            }
        }
    }
}

__device__ __forceinline__ void wb_arrive(const Ctx& cx) {
    asm volatile("s_waitcnt vmcnt(0)" ::: "memory");
    __syncthreads();
    if (cx.tid == 0) {
        unsigned* c = (unsigned*)(cx.ws + OFF_SM + SM_CNT);
        __builtin_amdgcn_fence(__ATOMIC_RELEASE, "agent");
        asm volatile("s_waitcnt vmcnt(0)" ::: "memory");
        (void)__hip_atomic_fetch_add(c, 1u, __ATOMIC_RELAXED, __HIP_MEMORY_SCOPE_AGENT);
    }
}
__device__ __forceinline__ void wb_wait(const Ctx& cx, unsigned want) {
    asm volatile("s_waitcnt vmcnt(0)" ::: "memory");
    __syncthreads();
    if (cx.tid == 0) {
        unsigned* c = (unsigned*)(cx.ws + OFF_SM + SM_CNT);
        unsigned spins = 0;
        while (__hip_atomic_load(c, __ATOMIC_RELAXED, __HIP_MEMORY_SCOPE_AGENT) < want) { __builtin_amdgcn_s_sleep(1); if (++spins > (1u << 22)) break; }
        __builtin_amdgcn_fence(__ATOMIC_ACQUIRE, "agent");
        asm volatile("s_waitcnt vmcnt(0)" ::: "memory");
    }
    __syncthreads();
}
__device__ __forceinline__ void phase_mix(const Params& p, const Ctx& cx, int l) {
    if (cx.bid < 64) { rwkv_scan(p, cx, l, cx.bid); }
    else {
        Ctx cw = cx; cw.bid = cx.bid - 64; cw.nb = 192;
        attn_phase(p, cw, l); hgrn_m1(p, cw, l); lru_m1(p, cw, l);
        int tlc = 0;
        wb_arrive(cx);
        if (l < 3) { phase_convw(p, cw, l + 1, tlc, tlc + 1152); tlc += 1152; }
        wb_wait(cx, 192u * (unsigned)(2 * l + 1));
        if (cw.bid < 128) { Ctx cs = cw; cs.nb = 128; hgrn_state_scan(p, cs); }
        else { const int c0 = (cw.bid - 128) * 16 + (cx.tid >> 6) * 2; lru_carry_wave(cx, c0); lru_carry_wave(cx, c0 + 1); }
        wb_arrive(cx);
        if (l < 3) { phase_convw(p, cw, l + 1, tlc, tlc + 1152); tlc += 1152; }
        wb_wait(cx, 192u * (unsigned)(2 * l + 2));
        hgrn_m3(p, cw, l); lru_m3(p, cw, l);
        if (l < 3) phase_convw(p, cw, l + 1, tlc, 3136);
    }
}

constexpr int PPL = 9;
constexpr int N_PHASES = 1 + 4 * PPL;
__device__ __forceinline__ void run_phase(const Params& p, const Ctx& cx, int ph) {
    const bf16_t* xb = (const bf16_t*)(cx.ws + OFF_XB);
    const float* rinv = (const float*)(cx.ws + OFF_SM + SM_RINV);
    const bf16_t* gA = nullptr; const bf16_t* gB = nullptr; bf16_t* gO = nullptr; int gN = 0, gK = 0, gld = 0, gncv = 0, gepi = -1;
    if (ph == 0) { phase_row(p, cx, 0, 0); phase_convw(p, cx, 0); phase_lb(p, cx); }
    else {
        const int l = (ph - 1) / PPL, k = (ph - 1) % PPL;
        switch (k) {
        case 0: gA = xb; gB = (const bf16_t*)(wbase(cx, l) + OFF_WIN); gO = (bf16_t*)(cx.ws + OFF_PH); gN = DINP; gK = 1024; gld = DIN; gncv = DIN; gepi = EPI_PROJ; break;
        case 1: rwkv_pre(p, cx, l); break;
        case 2: phase_mix(p, cx, l); break;
        case 3: rwkv_post(p, cx, l); break;
        case 4: gA = (const bf16_t*)(cx.ws + OFF_MIX); gB = (const bf16_t*)(wbase(cx, l) + OFF_WOUT); gO = (bf16_t*)(cx.ws + OFF_PH); gN = 1024; gK = 1024; gld = 1024; gncv = 1024; gepi = EPI_FF; break;
        case 5: phase_row(p, cx, 1, l); break;
        case 6: gA = xb; gB = (const bf16_t*)(wbase(cx, l) + OFF_W1); gO = (bf16_t*)(cx.ws + OFF_PH); gN = 4096; gK = 1024; gld = 4096; gncv = 4096; gepi = EPI_UP; break;
        case 7: gA = (const bf16_t*)(cx.ws + OFF_PH); gB = (const bf16_t*)(wbase(cx, l) + OFF_W2); gO = (bf16_t*)(cx.ws + OFF_MIX); gN = 1024; gK = 4096; gld = 1024; gncv = 1024; gepi = EPI_FF; break;
        case 8: phase_row(p, cx, 2, l); break;
        }
    }
    if (gepi >= 0) gemm_phase(cx, gepi, gA, gB, T, gN, gK, gO, gld, gncv, rinv);
}

__global__ void __launch_bounds__(512, 2) fwd_kernel(Params p, int ph_lo, int ph_hi) {
    extern __shared__ __attribute__((aligned(16))) bf16_t shm[];
    cg::grid_group grid = cg::this_grid();
    volatile LAS unsigned* st = (volatile LAS unsigned*)((LAS char*)shm + 131072);
    if (threadIdx.x == 0) { st[0] = 0u; st[1] = 0u; }
    __syncthreads();
    XcdBarrier xb = xcd_barrier_post((unsigned*)(p.ws + OFF_SM + SM_BAR), st);
    for (int ph = ph_lo; ph < ph_hi; ++ph) {
        Ctx cx;
        cx.tid = threadIdx.x; cx.bid = blockIdx.x; cx.nb = gridDim.x; cx.ws = p.ws; cx.out = p.out; cx.z = 0;
        asm volatile("" : "+v"(cx.tid));
        asm volatile("" : "+s"(cx.bid), "+s"(cx.nb), "+s"(cx.ws), "+s"(cx.out), "+s"(cx.z));
        run_phase(p, cx, ph);
        if (ph + 1 < ph_hi) { if (ph == ph_lo) grid.sync(); else xcd_barrier(xb); }
    }
}

extern "C" void kernel_launch(void* const* d_in, const int* in_sizes, int n_in, void* d_out, int out_size, void* d_ws, size_t ws_size, hipStream_t stream) {
    static int grid_blocks = 0;
    if (!grid_blocks) {
        int dev = 0, cus = 0, per_cu = 0;
        (void)hipGetDevice(&dev);
        (void)hipDeviceGetAttribute(&cus, hipDeviceAttributeMultiprocessorCount, dev);
        (void)hipFuncSetAttribute((const void*)fwd_kernel, hipFuncAttributeMaxDynamicSharedMemorySize, LDS_BYTES);
        (void)hipOccupancyMaxActiveBlocksPerMultiprocessor(&per_cu, (const void*)fwd_kernel, 512, LDS_BYTES);
        if (per_cu < 1) per_cu = 1;
        grid_blocks = cus * per_cu;
        if (grid_blocks > 256) grid_blocks = 256;
        if (ws_size < 510 * MiB) fprintf(stderr, "kernel_launch: workspace too small: %zu\n", ws_size);
    }
    (void)hipMemsetAsync((char*)d_ws + OFF_SM + SM_BAR, 0, 16384 + 256, stream);
    Params p{};
    for (int i = 0; i < 30; ++i) p.in[i] = (const float*)d_in[i];
    p.out = (float*)d_out; p.ws = (char*)d_ws;
#if MEGA
    int lo = 0, hi = N_PHASES;
    void* args[] = {&p, &lo, &hi};
    hipError_t e = hipLaunchCooperativeKernel((const void*)fwd_kernel, dim3(grid_blocks), dim3(512), args, LDS_BYTES, stream);
    if (e != hipSuccess) fprintf(stderr, "cooperative launch failed: %s (grid %d)\n", hipGetErrorString(e), grid_blocks);
#else
    for (int ph = 0; ph < N_PHASES; ++ph) hipLaunchKernelGGL(fwd_kernel, dim3(grid_blocks), dim3(512), LDS_BYTES, stream, p, ph, ph + 1);
#endif
}
```

```cpp
#include <hip/hip_runtime.h>
#include <hip/hip_cooperative_groups.h>
#include <cstdio>
namespace cg = cooperative_groups;

#ifndef MEGA
#define MEGA 1
#endif
#ifndef DUP
#define DUP 0
#endif

typedef unsigned short bf16_t;
typedef short bf16x8 __attribute__((ext_vector_type(8)));
typedef short bf16x4 __attribute__((ext_vector_type(4)));
typedef float f32x4 __attribute__((ext_vector_type(4)));
typedef float f32x2 __attribute__((ext_vector_type(2)));

constexpr int T = 32768, SEQ = 8192, DIN = 3200, DINP = 3328;
constexpr size_t MiB = 1u << 20;
constexpr size_t OFF_WIN = 0;
constexpr size_t OFF_WOUT = OFF_WIN + (size_t)DINP * 1024 * 2;
constexpr size_t OFF_W1 = OFF_WOUT + (size_t)1024 * 1024 * 2;
constexpr size_t OFF_W2 = OFF_W1 + (size_t)4096 * 1024 * 2;
constexpr size_t OFF_PH = 26 * MiB;
constexpr size_t OFF_HU = OFF_PH + 200 * MiB;
constexpr size_t OFF_MIX = OFF_PH + 256 * MiB;
constexpr size_t OFF_XB = OFF_MIX + 64 * MiB;
constexpr size_t OFF_LP = OFF_XB + 16 * MiB;
constexpr size_t OFF_RW = OFF_XB + 64 * MiB;
constexpr size_t OFF_SM = OFF_RW + 96 * MiB;
constexpr size_t SM_RINV = 0, SM_LB = 128 * 1024, SM_DEC = 256 * 1024, SM_HEND = 1 * MiB, SM_PTOT = 2 * MiB, SM_CARRY = 3 * MiB;
constexpr int LDS_BYTES = 131072 + 16;
constexpr size_t SM_BAR = 4 * MiB, SM_CNT = 4 * MiB + 16384;

struct Params { const float* in[30]; float* out; char* ws; };
struct Ctx { int tid, bid, nb, z; char* ws; float* out; };
__device__ __forceinline__ char* wbase(const Ctx& cx, int l) { return (l & 1) ? ((char*)cx.out + 80 * (size_t)(1u << 20)) : cx.ws; }

__device__ __forceinline__ float bf2f(bf16_t h) { return __uint_as_float(((unsigned)h) << 16); }
__device__ __forceinline__ unsigned pk_bf16(float lo, float hi) { unsigned r; asm("v_cvt_pk_bf16_f32 %0, %1, %2" : "=v"(r) : "v"(lo), "v"(hi)); return r; }
__device__ __forceinline__ bf16_t f2bf(float f) { return (bf16_t)(pk_bf16(f, 0.f) & 0xffffu); }
__device__ __forceinline__ float shx(float v, int lane, int m) { return __int_as_float(__builtin_amdgcn_ds_bpermute((lane ^ m) << 2, __float_as_int(v))); }
template <int CTRL> __device__ __forceinline__ float dpp_f(float x) { return __int_as_float(__builtin_amdgcn_update_dpp(0, __float_as_int(x), CTRL, 0xF, 0xF, true)); }
__device__ __forceinline__ float row16_sum(float x) {
    x += dpp_f<0xB1>(x);
    x += dpp_f<0x4E>(x);
    x += dpp_f<0x141>(x);
    x += dpp_f<0x140>(x);
    return x;
}
__device__ __forceinline__ float rdlane(float v, int l) { return __int_as_float(__builtin_amdgcn_readlane(__float_as_int(v), l)); }
__device__ __forceinline__ float wave_sum(float v) {
    v = row16_sum(v);
    return (rdlane(v, 0) + rdlane(v, 16)) + (rdlane(v, 32) + rdlane(v, 48));
}
__device__ __forceinline__ float sigm(float x) { return __builtin_amdgcn_rcpf(1.0f + __expf(-x)); }


#define XB_TMO      128
#define XB_XCNT(j)  (256  + 64 * (j))
#define XB_XSUB(j)  (1280 + 64 * (j))
#define XB_XGEN(j)  (2304 + 64 * (j))
#define XB_TOP      3328
#define XB_TOPGEN   3392
#define XCD_BAR_WORDS 3456
#define XB_SPIN_CAP (1u << 18)
#define LAS __attribute__((address_space(3)))
__device__ __forceinline__ unsigned xb_ld(unsigned* p)              { return __hip_atomic_load(p, __ATOMIC_RELAXED, __HIP_MEMORY_SCOPE_AGENT); }
__device__ __forceinline__ unsigned xb_add(unsigned* p, unsigned v) { return __hip_atomic_fetch_add(p, v, __ATOMIC_RELAXED, __HIP_MEMORY_SCOPE_AGENT); }
__device__ __forceinline__ unsigned xb_xcc_id() { return (unsigned)__builtin_amdgcn_s_getreg((3 << 11) | 20) & 0xFu; }
#define XB_SPIN(cond, bar) do { unsigned _sp = 0; while (cond) { __builtin_amdgcn_s_sleep(1); \
    if ((++_sp & 255u) == 0u) { if (xb_ld(&(bar)[XB_TMO])) break; if (_sp > XB_SPIN_CAP) { atomicAdd(&(bar)[XB_TMO], 1u); break; } } } } while (0)
struct XcdBarrier { unsigned* bar; unsigned x; volatile LAS unsigned* st; };
__device__ __forceinline__ XcdBarrier xcd_barrier_post(unsigned* bar, volatile LAS unsigned* st) {
    XcdBarrier b; b.bar = bar; b.x = xb_xcc_id(); b.st = st;
    if (threadIdx.x == 0) (void)xb_add(&bar[XB_XCNT(b.x)], 1u);
    return b;
}
__device__ __forceinline__ void xcd_barrier_complete(unsigned* bar, unsigned x, unsigned& nloc, unsigned& nx) {
    const unsigned G = gridDim.x * gridDim.y * gridDim.z;
    unsigned sum, cnt, mine, sp = 0u;
    for (;;) {
        sum = 0u; cnt = 0u; mine = 0u;
#pragma unroll
        for (unsigned j = 0; j < 16; ++j) { const unsigned c = xb_ld(&bar[XB_XCNT(j)]); sum += c; cnt += (c > 0u) ? 1u : 0u; mine = (j == x) ? c : mine; }
        if (sum == G) break;
        __builtin_amdgcn_s_sleep(1);
        if ((++sp & 255u) == 0u) { if (xb_ld(&bar[XB_TMO])) break; if (sp > XB_SPIN_CAP) { atomicAdd(&bar[XB_TMO], 1u); break; } }
    }
    nloc = mine > 0u ? mine : 1u; nx = cnt > 0u ? cnt : 1u;
}
__device__ __forceinline__ void xcd_barrier(const XcdBarrier& b) {
    asm volatile("s_waitcnt vmcnt(0)" ::: "memory");
    __syncthreads();
    if (threadIdx.x == 0) {
        unsigned* bar = b.bar;
        __builtin_amdgcn_s_waitcnt(0);
        unsigned nloc = b.st[0], nx = b.st[1];
        if (nloc == 0u) { xcd_barrier_complete(bar, b.x, nloc, nx); b.st[0] = nloc; b.st[1] = nx; }
        const unsigned old = xb_add(&bar[XB_XSUB(b.x)], 1u);
        const unsigned gen = old / nloc;
        if (old + 1u == (gen + 1u) * nloc) {
            __builtin_amdgcn_fence(__ATOMIC_RELEASE, "agent");
            asm volatile("s_waitcnt vmcnt(0)" ::: "memory");
            const unsigned og = xb_add(&bar[XB_TOP], 1u);
            const unsigned tg = og / nx;
            if (og + 1u == (tg + 1u) * nx) xb_add(&bar[XB_TOPGEN], 1u);
            else XB_SPIN(xb_ld(&bar[XB_TOPGEN]) == tg, bar);
            __builtin_amdgcn_fence(__ATOMIC_ACQUIRE, "agent");
            xb_add(&bar[XB_XGEN(b.x)], 1u);
            asm volatile("s_waitcnt vmcnt(0)" ::: "memory");
        } else {
            XB_SPIN(xb_ld(&bar[XB_XGEN(b.x)]) == gen, bar);
            __builtin_amdgcn_fence(__ATOMIC_ACQUIRE, "agent");
            asm volatile("s_waitcnt vmcnt(0)" ::: "memory");
        }
    }
    __syncthreads();
}

constexpr int BM = 256, BK = 64, HALF = 128, HT = HALF * BK, NXCD = 8, WGM = 8;
__device__ __forceinline__ int lds_byte(int r, int c) {
    int st = (r >> 4) * 2 + (c >> 5), rr = r & 15, cc = c & 31, ob = rr * 64 + cc * 2;
    return st * 1024 + (ob ^ (((ob >> 9) & 1) << 5));
}
__device__ __forceinline__ void stage_rc(int b, int& R, int& C) {
    int st = b / 1024, sb = b % 1024, swz = sb ^ (((sb >> 9) & 1) << 5);
    R = (st >> 1) * 16 + swz / 64; C = (st & 1) * 32 + (swz % 64) / 2;
}
enum { EPI_PROJ = 0, EPI_FF = 1, EPI_UP = 2 };

__device__ __forceinline__ void gemm_tile(const Ctx& cx, const int EPI, const bf16_t* __restrict__ A, const bf16_t* __restrict__ Bt, const int K, const int brow, const int bcol,
                                          bf16_t* __restrict__ O, const int ldo, const int ncv, const float* __restrict__ rinv) {
    extern __shared__ __attribute__((aligned(16))) bf16_t shm[];
#define SA(b, h) (shm + ((b) * 2 + (h)) * HT)
#define SB(b, h) (shm + (4 + (b) * 2 + (h)) * HT)
#define STAGE(P, BASE, br, kt) do { const char* _ub = (const char*)(BASE) + ((size_t)(br) * (size_t)K + (size_t)(kt) * BK) * 2; \
    for (int _i = 0; _i < 2; ++_i) { unsigned _o = roff[_i]; asm volatile("" : "+v"(_o)); \
      __builtin_amdgcn_global_load_lds((const unsigned*)(_ub + _o), (unsigned*)((char*)(P) + cx.tid * 16 + _i * 8192), 16, 0, 0); } } while (0)
#define LDA(dst, b, h) for (int m = 0; m < 4; ++m) for (int k = 0; k < 2; ++k) \
    dst[m][k] = *reinterpret_cast<const bf16x8*>((char*)SA(b, h) + lds_byte(wr * 64 + m * 16 + fr, k * 32 + fq * 8))
#define LDB(dst, b, h) for (int n = 0; n < 2; ++n) for (int k = 0; k < 2; ++k) \
    dst[n][k] = *reinterpret_cast<const bf16x8*>((char*)SB(b, h) + lds_byte(wc * 32 + n * 16 + fr, k * 32 + fq * 8))
#define MMA(ai, bj, At_, Bt_) do { __builtin_amdgcn_s_setprio(1); \
    for (int m = 0; m < 4; ++m) for (int n = 0; n < 2; ++n) for (int k = 0; k < 2; ++k) \
      acc[ai][bj][m][n] = __builtin_amdgcn_mfma_f32_16x16x32_bf16(Bt_[n][k], At_[m][k], acc[ai][bj][m][n], 0, 0, 0); \
    __builtin_amdgcn_s_setprio(0); } while (0)
#define WAIT_V(n) asm volatile("s_waitcnt vmcnt(" #n ")" ::: "memory")
#define WAIT_L(n) asm volatile("s_waitcnt lgkmcnt(" #n ")" ::: "memory")
#define BAR __builtin_amdgcn_s_barrier()
#define SCHED __builtin_amdgcn_sched_barrier(0)
    const int wid = cx.tid >> 6, lane = cx.tid & 63, wr = wid >> 2, wc = wid & 3, fr = lane & 15, fq = lane >> 4;
    f32x4 acc[2][2][4][2] = {};
    bf16x8 At[4][2], B0[2][2], B1[2][2];
    const int nt = K / BK;
    unsigned roff[2];
#pragma unroll
    for (int _i = 0; _i < 2; ++_i) { int _r, _c; stage_rc(cx.tid * 16 + _i * 8192, _r, _c); roff[_i] = (unsigned)(_r * K + _c) * 2u; }
    STAGE(SB(0, 0), Bt, bcol, 0); STAGE(SA(0, 0), A, brow, 0);
    STAGE(SB(0, 1), Bt, bcol + HALF, 0); STAGE(SA(0, 1), A, brow + HALF, 0);
    if (wr == 1) BAR;
    WAIT_V(4); BAR;
    STAGE(SB(1, 0), Bt, bcol, 1); STAGE(SA(1, 0), A, brow, 1); STAGE(SB(1, 1), Bt, bcol + HALF, 1);
    WAIT_V(6); BAR;
    for (int t = 0; t < nt - 2; t += 2) {
        LDB(B0, 0, 0); SCHED; LDA(At, 0, 0); STAGE(SA(1, 1), A, brow + HALF, t + 1);
        WAIT_L(8); BAR; WAIT_L(0); MMA(0, 0, At, B0); BAR; SCHED;
        LDB(B1, 0, 1); STAGE(SB(0, 0), Bt, bcol, t + 2);
        BAR; WAIT_L(0); MMA(0, 1, At, B1); BAR;
        LDA(At, 0, 1); STAGE(SA(0, 0), A, brow, t + 2);
        BAR; WAIT_L(0); MMA(1, 0, At, B0); BAR; SCHED;
        STAGE(SB(0, 1), Bt, bcol + HALF, t + 2);
        WAIT_V(6); BAR; MMA(1, 1, At, B1); BAR;
        LDB(B0, 1, 0); SCHED; LDA(At, 1, 0); STAGE(SA(0, 1), A, brow + HALF, t + 2);
        WAIT_L(8); BAR; WAIT_L(0); MMA(0, 0, At, B0); BAR; SCHED;
        LDB(B1, 1, 1); STAGE(SB(1, 0), Bt, bcol, t + 3);
        BAR; WAIT_L(0); MMA(0, 1, At, B1); BAR;
        LDA(At, 1, 1); STAGE(SA(1, 0), A, brow, t + 3);
        BAR; WAIT_L(0); MMA(1, 0, At, B0); BAR; SCHED;
        STAGE(SB(1, 1), Bt, bcol + HALF, t + 3);
        WAIT_V(6); BAR; MMA(1, 1, At, B1); BAR;
    }
    { LDB(B0, 0, 0); LDA(At, 0, 0); STAGE(SA(1, 1), A, brow + HALF, nt - 1);
      BAR; WAIT_L(0); MMA(0, 0, At, B0); BAR;
      LDB(B1, 0, 1); BAR; WAIT_L(0); MMA(0, 1, At, B1); BAR;
      LDA(At, 0, 1); WAIT_V(4); BAR; WAIT_L(0); MMA(1, 0, At, B0); MMA(1, 1, At, B1); BAR; }
    { LDB(B0, 1, 0); LDA(At, 1, 0); WAIT_V(2); BAR; WAIT_L(0); MMA(0, 0, At, B0); BAR;
      LDB(B1, 1, 1); WAIT_V(0); BAR; WAIT_L(0); MMA(0, 1, At, B1); BAR;
      LDA(At, 1, 1); BAR; WAIT_L(0); MMA(1, 0, At, B0); MMA(1, 1, At, B1); BAR; }
    if (wr == 0) BAR;
#pragma unroll
    for (int ai = 0; ai < 2; ++ai)
#pragma unroll
        for (int m = 0; m < 4; ++m) {
            const int row = brow + ai * HALF + wr * 64 + m * 16 + fr;
            float rs = 1.0f;
            if (EPI != EPI_FF) rs = rinv[row];
            bf16_t* orow = O + (size_t)row * ldo;
#pragma unroll
            for (int bj = 0; bj < 2; ++bj)
#pragma unroll
                for (int n = 0; n < 2; ++n) {
                    const int col = bcol + bj * HALF + wc * 32 + n * 16 + fq * 4;
                    f32x4 v = acc[ai][bj][m][n];
                    if (EPI != EPI_FF) v *= rs;
                    if (EPI == EPI_UP) {
#pragma unroll
                        for (int j = 0; j < 4; ++j) { float r = fmaxf(v[j], 0.f); v[j] = r * r; }
                    }
                    if (col < ncv) { uint2 w; w.x = pk_bf16(v[0], v[1]); w.y = pk_bf16(v[2], v[3]); *(uint2*)(orow + col) = w; }
                }
        }
#undef SA
#undef SB
#undef STAGE
#undef LDA
#undef LDB
#undef MMA
}

__device__ __forceinline__ void gemm_phase(const Ctx& cx, const int EPI, const bf16_t* A, const bf16_t* Bt, int M, int N, int K, bf16_t* O, int ldo, int ncv, const float* rinv) {
    const int nM = M / BM, nN = N / BM, nwg = nM * nN;
    for (int i = 0;; ++i) {
        const long L = (long)i * cx.nb + cx.bid;
        if (L >= nwg) break;
        int wgid = (int)L;
        { const int q = nwg / NXCD, r = nwg % NXCD, xcd = wgid % NXCD, off = wgid / NXCD; wgid = (xcd < r ? xcd * (q + 1) : r * (q + 1) + (xcd - r) * q) + off; }
        const int nig = WGM * nN, gid = wgid / nig, fm = gid * WGM, gsz = (nM - fm) < WGM ? (nM - fm) : WGM;
        const int pm = fm + ((wgid % nig) % gsz), pn = (wgid % nig) / gsz;
        gemm_tile(cx, EPI, A, Bt, K, pm * BM, pn * BM, O, ldo, ncv, rinv);
        __syncthreads();
    }
}

template <int NR>
__device__ __forceinline__ void rows_do(const Params& p, const Ctx& cx, int mode, int l, int row0) {
    const bf16_t* ff = (const bf16_t*)(cx.ws + (mode == 1 ? OFF_PH : OFF_MIX));
    const float* gain = (mode == 1 ? p.in[2 + cx.z] : p.in[4 + cx.z]) + l * 1024;
    bf16_t* xb = (bf16_t*)(cx.ws + OFF_XB);
    float* rinv = (float*)(cx.ws + OFF_SM + SM_RINV);
    const int lane = cx.tid & 63;
    const bool fin = (mode == 2 && l == 3);
    float4 xv[NR][4];
    uint2 fu[NR][4];
#pragma unroll
    for (int r = 0; r < NR; ++r) {
        const size_t row = (size_t)(row0 + r);
#pragma unroll
        for (int i = 0; i < 4; ++i) {
            if (mode == 0) xv[r][i] = ((const float4*)(p.in[0 + cx.z] + row * 1024))[i * 64 + lane];
            else {
                const uint2 u = ((const uint2*)(xb + row * 1024))[i * 64 + lane];
                xv[r][i].x = __uint_as_float(u.x << 16); xv[r][i].y = __uint_as_float(u.x & 0xffff0000u);
                xv[r][i].z = __uint_as_float(u.y << 16); xv[r][i].w = __uint_as_float(u.y & 0xffff0000u);
                fu[r][i] = ((const uint2*)(ff + row * 1024))[i * 64 + lane];
            }
        }
    }
#pragma unroll
    for (int r = 0; r < NR; ++r) {
        const size_t row = (size_t)(row0 + r);
        if (mode) {
            float fv[4][4]; float ss = 0.f;
#pragma unroll
            for (int i = 0; i < 4; ++i) {
                const uint2 u = fu[r][i];
                fv[i][0] = __uint_as_float(u.x << 16); fv[i][1] = __uint_as_float(u.x & 0xffff0000u);
                fv[i][2] = __uint_as_float(u.y << 16); fv[i][3] = __uint_as_float(u.y & 0xffff0000u);
                ss += fv[i][0] * fv[i][0] + fv[i][1] * fv[i][1] + fv[i][2] * fv[i][2] + fv[i][3] * fv[i][3];
            }
            ss = wave_sum(ss);
            const float sc = __builtin_amdgcn_rsqf(ss * (1.0f / 1024.0f) + 1e-6f);
#pragma unroll
            for (int i = 0; i < 4; ++i) {
                const float4 g = ((const float4*)gain)[i * 64 + lane];
                xv[r][i].x += fv[i][0] * sc * g.x; xv[r][i].y += fv[i][1] * sc * g.y; xv[r][i].z += fv[i][2] * sc * g.z; xv[r][i].w += fv[i][3] * sc * g.w;
            }
        }
        if (fin) {
#pragma unroll
            for (int i = 0; i < 4; ++i) ((float4*)(cx.out + row * 1024))[i * 64 + lane] = xv[r][i];
        } else {
            float s2 = 0.f;
#pragma unroll
            for (int i = 0; i < 4; ++i) s2 += xv[r][i].x * xv[r][i].x + xv[r][i].y * xv[r][i].y + xv[r][i].z * xv[r][i].z + xv[r][i].w * xv[r][i].w;
            s2 = wave_sum(s2);
            if (lane == 0) rinv[row] = __builtin_amdgcn_rsqf(s2 * (1.0f / 1024.0f) + 1e-6f);
#pragma unroll
            for (int i = 0; i < 4; ++i) {
                uint2 w; w.x = pk_bf16(xv[r][i].x, xv[r][i].y); w.y = pk_bf16(xv[r][i].z, xv[r][i].w);
                ((uint2*)(xb + row * 1024))[i * 64 + lane] = w;
            }
        }
    }
}
__device__ __forceinline__ void phase_row(const Params& p, const Ctx& cx, int mode, int l, bool dry = false) {
    const int wave = cx.tid >> 6;
    for (int row = (cx.bid * 8 + wave) * 4; row < T; row += cx.nb * 8 * 4) rows_do<4>(p, cx, mode, l, row);
}

__device__ __forceinline__ void phase_convw(const Params& p, const Ctx& cx, int l, int tl0 = 0, int tl1 = 3136) {
    extern __shared__ __attribute__((aligned(16))) bf16_t shm[];
    float* tile = (float*)shm;
    const int tid = cx.tid;
    char* wb_ = wbase(cx, l);
    for (int tl = tl0 + cx.bid; tl < tl1; tl += cx.nb) {
        const float* W; const float* g; bf16_t* Wt; int K, N, nNt, loc;
        if (tl < 832) { W = p.in[5 + cx.z] + (size_t)l * 1024 * 3200; g = p.in[1 + cx.z] + l * 1024; Wt = (bf16_t*)(wb_ + OFF_WIN); K = 1024; N = 3200; nNt = 52; loc = tl; }
        else if (tl < 1088) { W = p.in[6 + cx.z] + (size_t)l * 1024 * 1024; g = nullptr; Wt = (bf16_t*)(wb_ + OFF_WOUT); K = 1024; N = 1024; nNt = 16; loc = tl - 832; }
        else if (tl < 2112) { W = p.in[28 + cx.z] + (size_t)l * 1024 * 4096; g = p.in[3 + cx.z] + l * 1024; Wt = (bf16_t*)(wb_ + OFF_W1); K = 1024; N = 4096; nNt = 64; loc = tl - 1088; }
        else { W = p.in[29 + cx.z] + (size_t)l * 4096 * 1024; g = nullptr; Wt = (bf16_t*)(wb_ + OFF_W2); K = 4096; N = 1024; nNt = 16; loc = tl - 2112; }
        const int k0 = (loc / nNt) * 64, n0 = (loc % nNt) * 64;
#pragma unroll
        for (int i = 0; i < 8; ++i) {
            const int k = i * 8 + (tid >> 6), n = tid & 63;
            float v = 0.f;
            if (n0 + n < N) { v = W[(size_t)(k0 + k) * N + n0 + n]; if (g) v *= g[k0 + k]; }
            tile[k * 65 + n] = v;
        }
        __syncthreads();
#pragma unroll
        for (int i = 0; i < 4; ++i) {
            const int n = i * 16 + (tid >> 5), k = (tid & 31) * 2;
            *(unsigned*)(Wt + (size_t)(n0 + n) * K + k0 + k) = pk_bf16(tile[k * 65 + n], tile[(k + 1) * 65 + n]);
        }
        __syncthreads();
    }
}

__device__ __forceinline__ void phase_lb(const Params& p, const Ctx& cx) {
    if (cx.bid == 0 && cx.tid < 256) {
        const int c = cx.tid;
        float v[4], mx = -1e30f;
        for (int l = 0; l < 4; ++l) { v[l] = p.in[8 + cx.z][l * 256 + c]; mx = fmaxf(mx, v[l]); }
        float s = 0.f;
        for (int l = 0; l < 4; ++l) { v[l] = expf(v[l] - mx); s += v[l]; }
        float* lb = (float*)(cx.ws + OFF_SM + SM_LB);
        float cum = 0.f;
        for (int l = 0; l < 4; ++l) { if (l > 0) cum += v[l] / s; lb[l * 256 + c] = fmaxf(cum, 0.f); }
    }
}

__device__ __forceinline__ void attn_phase(const Params& p, const Ctx& cx, int l) {
    extern __shared__ __attribute__((aligned(16))) bf16_t shm[];
    bf16_t* vT = shm;
    float* sb = (float*)((char*)shm + 69632);
    const bf16_t* proj = (const bf16_t*)(cx.ws + OFF_PH);
    bf16_t* mix = (bf16_t*)(cx.ws + OFF_MIX);
    const int tid = cx.tid, w = tid >> 6, lane = tid & 63, fr = lane & 15, fq = lane >> 4;
    const int h = w >> 1, qh = w & 1;
    for (int i = tid; i < 2052; i += 512) sb[i] = p.in[7 + cx.z][l * 2052 + i];
    const float* sbh = sb + h * 513;
    for (int item = cx.bid; item < 512; item += cx.nb) {
        const int b = item >> 7, c = item & 127;
        const size_t tq = (size_t)b * SEQ + c * 64;
        bf16x8 Qf[2][2];
#pragma unroll
        for (int qt = 0; qt < 2; ++qt)
#pragma unroll
            for (int ks = 0; ks < 2; ++ks)
                Qf[qt][ks] = *(const bf16x8*)(proj + (tq + qh * 32 + qt * 16 + fr) * DIN + h * 64 + ks * 32 + fq * 8);
        f32x4 O[4][2];
#pragma unroll
        for (int dt = 0; dt < 4; ++dt) { O[dt][0] = (f32x4){0.f, 0.f, 0.f, 0.f}; O[dt][1] = (f32x4){0.f, 0.f, 0.f, 0.f}; }
        float mrun[2] = {-1e30f, -1e30f}, lsum[2] = {0.f, 0.f};
        const int j0 = (8 - c) > 0 ? (8 - c) : 0;
        auto stage = [&](int j, int buf) {
            const size_t tk = (size_t)b * SEQ + (size_t)(c - 8 + j) * 64;
#pragma unroll
            for (int i = 0; i < 4; ++i) {
                const int idx = i * 512 + tid, key = idx & 63, cgp = idx >> 6;
                const bf16x8 v = *(const bf16x8*)(proj + (tk + key) * DIN + 512 + cgp * 8);
                const int hd = cgp >> 3, d0 = (cgp & 7) * 8;
#pragma unroll
                for (int jj = 0; jj < 8; ++jj) vT[((buf * 4 + hd) * 64 + d0 + jj) * 68 + key] = (bf16_t)v[jj];
            }
        };
        __syncthreads();
        stage(j0, 0);
        bf16x8 Kc[4][2];
        {
            const size_t tk0 = (size_t)b * SEQ + (size_t)(c - 8 + j0) * 64;
#pragma unroll
            for (int kt = 0; kt < 4; ++kt) {
                Kc[kt][0] = *(const bf16x8*)(proj + (tk0 + kt * 16 + fr) * DIN + 256 + h * 64 + fq * 8);
                Kc[kt][1] = *(const bf16x8*)(proj + (tk0 + kt * 16 + fr) * DIN + 256 + h * 64 + 32 + fq * 8);
            }
        }
        __syncthreads();
        for (int j = j0; j <= 8; ++j) {
            const int cur = (j - j0) & 1;
            if (j < 8) stage(j + 1, cur ^ 1);
            const size_t tk = (size_t)b * SEQ + (size_t)(c - 8 + j) * 64;
            f32x4 S[4][2];
#pragma unroll
            for (int kt = 0; kt < 4; ++kt) {
#pragma unroll
                for (int qt = 0; qt < 2; ++qt) {
                    f32x4 a = (f32x4){0.f, 0.f, 0.f, 0.f};
                    a = __builtin_amdgcn_mfma_f32_16x16x32_bf16(Kc[kt][0], Qf[qt][0], a, 0, 0, 0);
                    a = __builtin_amdgcn_mfma_f32_16x16x32_bf16(Kc[kt][1], Qf[qt][1], a, 0, 0, 0);
                    S[kt][qt] = a;
                }
            }
            if (j < 8) {
#pragma unroll
                for (int kt = 0; kt < 4; ++kt) {
                    Kc[kt][0] = *(const bf16x8*)(proj + (tk + 64 + kt * 16 + fr) * DIN + 256 + h * 64 + fq * 8);
                    Kc[kt][1] = *(const bf16x8*)(proj + (tk + 64 + kt * 16 + fr) * DIN + 256 + h * 64 + 32 + fq * 8);
                }
            }
            const int relbase = (j - 8) * 64 - (qh * 32 + fr) + fq * 4;
#pragma unroll
            for (int qt = 0; qt < 2; ++qt) {
                float mx = -1e30f;
#pragma unroll
                for (int kt = 0; kt < 4; ++kt)
#pragma unroll
                    for (int jj = 0; jj < 4; ++jj) {
                        int rel = relbase + kt * 16 + jj - qt * 16;
                        rel = rel < -256 ? -256 : (rel > 256 ? 256 : rel);
                        const float s = S[kt][qt][jj] * 0.125f + sbh[rel + 256];
                        S[kt][qt][jj] = s; mx = fmaxf(mx, s);
                    }
                mx = fmaxf(mx, shx(mx, lane, 16)); mx = fmaxf(mx, shx(mx, lane, 32));
                const float mn = fmaxf(mrun[qt], mx);
                const float alpha = __expf(mrun[qt] - mn);
                mrun[qt] = mn;
                float ps = 0.f;
#pragma unroll
                for (int kt = 0; kt < 4; ++kt)
#pragma unroll
                    for (int jj = 0; jj < 4; ++jj) { const float pv = __expf(S[kt][qt][jj] - mn); S[kt][qt][jj] = pv; ps += pv; }
                lsum[qt] = lsum[qt] * alpha + ps;
#pragma unroll
                for (int dt = 0; dt < 4; ++dt) O[dt][qt] *= alpha;
            }
#pragma unroll
            for (int gk = 0; gk < 2; ++gk) {
                bf16x8 Pf[2];
#pragma unroll
                for (int qt = 0; qt < 2; ++qt) {
                    union { unsigned u[4]; bf16x8 v; } cv;
                    cv.u[0] = pk_bf16(S[2 * gk][qt][0], S[2 * gk][qt][1]); cv.u[1] = pk_bf16(S[2 * gk][qt][2], S[2 * gk][qt][3]);
                    cv.u[2] = pk_bf16(S[2 * gk + 1][qt][0], S[2 * gk + 1][qt][1]); cv.u[3] = pk_bf16(S[2 * gk + 1][qt][2], S[2 * gk + 1][qt][3]);
                    Pf[qt] = cv.v;
                }
#pragma unroll
                for (int dt = 0; dt < 4; ++dt) {
                    const bf16_t* vp = vT + ((cur * 4 + h) * 64 + dt * 16 + fr) * 68 + gk * 32 + fq * 4;
                    union { uint2 u[2]; bf16x8 v; } vv;
                    vv.u[0] = *(const uint2*)vp; vv.u[1] = *(const uint2*)(vp + 16);
                    O[dt][0] = __builtin_amdgcn_mfma_f32_16x16x32_bf16(vv.v, Pf[0], O[dt][0], 0, 0, 0);
                    O[dt][1] = __builtin_amdgcn_mfma_f32_16x16x32_bf16(vv.v, Pf[1], O[dt][1], 0, 0, 0);
                }
            }
            __syncthreads();
        }
#pragma unroll
        for (int qt = 0; qt < 2; ++qt) {
            float lt = lsum[qt];
            lt += shx(lt, lane, 16); lt += shx(lt, lane, 32);
            const float inv = 1.0f / lt;
            bf16_t* orow = mix + (tq + qh * 32 + qt * 16 + fr) * 1024 + h * 64 + fq * 4;
#pragma unroll
            for (int dt = 0; dt < 4; ++dt) {
                uint2 wv; wv.x = pk_bf16(O[dt][qt][0] * inv, O[dt][qt][1] * inv); wv.y = pk_bf16(O[dt][qt][2] * inv, O[dt][qt][3] * inv);
                *(uint2*)(orow + dt * 16) = wv;
            }
        }
    }
    __syncthreads();
}

__device__ __forceinline__ void hgrn_m1(const Params& p, const Ctx& cx, int l) {
    extern __shared__ __attribute__((aligned(16))) bf16_t shm[];
    const int wave = cx.tid >> 6, lane = cx.tid & 63;
    float* sl = (float*)shm + wave * 3072;
    const bf16_t* proj = (const bf16_t*)(cx.ws + OFF_PH);
    bf16_t* mix = (bf16_t*)(cx.ws + OFF_MIX);
    float* U = (float*)(cx.ws + OFF_HU);
    float* dec = (float*)(cx.ws + OFF_SM + SM_DEC);
    const float* lbp = (const float*)(cx.ws + OFF_SM + SM_LB) + l * 256;
    for (int it = cx.bid * 8 + wave; it < 2048; it += cx.nb * 8) {
        const int bh = it >> 7, c = it & 127, b = bh >> 2, h = bh & 3;
        const size_t t0 = (size_t)b * SEQ + c * 64;
        const float lb = lbp[h * 64 + lane];
        f32x2 L[32];
#pragma unroll
        for (int k = 0; k < 32; ++k) L[k] = (f32x2){0.f, 0.f};
        float D = 1.f;
        for (int sub = 0; sub < 4; ++sub) {
            bf16_t qraw[16], fraw[16], iraw[16];
#pragma unroll
            for (int tt = 0; tt < 16; ++tt) {
                const bf16_t* row = proj + (t0 + sub * 16 + tt) * DIN + 768 + h * 64 + lane;
                qraw[tt] = row[0]; fraw[tt] = row[256]; iraw[tt] = row[512];
            }
#pragma unroll
            for (int tt = 0; tt < 16; ++tt) {
                const float qr = bf2f(qraw[tt]), fr_ = bf2f(fraw[tt]);
                const float e = __expf(-fr_), sg = 1.0f / (1.0f + e);
                const float f = lb + (1.f - lb) * sg, key = (1.f - lb) * e * sg;
                D *= f;
                sl[tt * 192 + lane] = f; sl[tt * 192 + 64 + lane] = key; sl[tt * 192 + 128 + lane] = qr * sigm(qr);
            }
            __builtin_amdgcn_fence(__ATOMIC_RELEASE, "wavefront");
            __builtin_amdgcn_wave_barrier();
#pragma unroll
            for (int tt = 0; tt < 16; ++tt) {
                const size_t t = t0 + sub * 16 + tt;
                const float iv = bf2f(iraw[tt]);
                const f32x2 iv2 = (f32x2){iv, iv};
                f32x2 o2 = (f32x2){0.f, 0.f};
                const float* sr = sl + tt * 192;
#pragma unroll
                for (int j = 0; j < 16; ++j) {
                    const f32x4 f4 = *(const f32x4*)(sr + 4 * j), k4 = *(const f32x4*)(sr + 64 + 4 * j), q4 = *(const f32x4*)(sr + 128 + 4 * j);
                    L[2 * j] = (f32x2){f4[0], f4[1]} * L[2 * j] + (f32x2){k4[0], k4[1]} * iv2;
                    o2 += (f32x2){q4[0], q4[1]} * L[2 * j];
                    L[2 * j + 1] = (f32x2){f4[2], f4[3]} * L[2 * j + 1] + (f32x2){k4[2], k4[3]} * iv2;
                    o2 += (f32x2){q4[2], q4[3]} * L[2 * j + 1];
                }
                mix[t * 1024 + 256 + h * 64 + lane] = f2bf(o2[0] + o2[1]);
            }
            __builtin_amdgcn_fence(__ATOMIC_RELEASE, "wavefront");
            __builtin_amdgcn_wave_barrier();
        }
#pragma unroll
        for (int k = 0; k < 32; ++k) { U[(size_t)it * 4096 + (2 * k) * 64 + lane] = L[k][0]; U[(size_t)it * 4096 + (2 * k + 1) * 64 + lane] = L[k][1]; }
        dec[it * 64 + lane] = D;
    }
    __syncthreads();
}

__device__ __forceinline__ void hgrn_m3(const Params& p, const Ctx& cx, int l, bool dry = false) {
    extern __shared__ __attribute__((aligned(16))) bf16_t shm[];
    const int wave = cx.tid >> 6, lane = cx.tid & 63;
    float* sl = (float*)shm + wave * 1024;
    const bf16_t* proj = (const bf16_t*)(cx.ws + OFF_PH);
    bf16_t* mix = (bf16_t*)(cx.ws + OFF_MIX);
    const float* U = (const float*)(cx.ws + OFF_HU);
    const float* lbp = (const float*)(cx.ws + OFF_SM + SM_LB) + l * 256;
    for (int it = cx.bid * 8 + wave; it < 2048; it += cx.nb * 8) {
        const int bh = it >> 7, c = it & 127, b = bh >> 2, h = bh & 3;
        const size_t t0 = (size_t)b * SEQ + c * 64;
        const float lb = lbp[h * 64 + lane];
        const float hn = p.in[9 + cx.z][l * 256 + h * 64 + lane];
        float S[64];
#pragma unroll
        for (int k = 0; k < 64; ++k) S[k] = U[(size_t)it * 4096 + k * 64 + lane];
        float G = 1.f;
        for (int sub = 0; sub < 4; ++sub) {
            bf16_t qraw[16], fraw[16], graw[16], oraw[16];
#pragma unroll
            for (int tt = 0; tt < 16; ++tt) {
                const size_t t = t0 + sub * 16 + tt;
                const bf16_t* row = proj + t * DIN + 768 + h * 64 + lane;
                qraw[tt] = row[0]; fraw[tt] = row[256]; graw[tt] = row[768];
                oraw[tt] = mix[t * 1024 + 256 + h * 64 + lane];
            }
#pragma unroll
            for (int tt = 0; tt < 16; ++tt) {
                const float qr = bf2f(qraw[tt]), fr_ = bf2f(fraw[tt]);
                const float f = lb + (1.f - lb) * sigm(fr_);
                G *= f;
                sl[tt * 64 + lane] = qr * sigm(qr) * G;
            }
            __builtin_amdgcn_fence(__ATOMIC_RELEASE, "wavefront");
            __builtin_amdgcn_wave_barrier();
#pragma unroll
            for (int tt = 0; tt < 16; ++tt) {
                const size_t t = t0 + sub * 16 + tt;
                const float* sr = sl + tt * 64;
                float o = 0.f;
#pragma unroll
                for (int j = 0; j < 16; ++j) {
                    const f32x4 q4 = *(const f32x4*)(sr + 4 * j);
                    o += q4[0] * S[4 * j] + q4[1] * S[4 * j + 1] + q4[2] * S[4 * j + 2] + q4[3] * S[4 * j + 3];
                }
                const size_t idx = t * 1024 + 256 + h * 64 + lane;
                o += bf2f(oraw[tt]);
                const float ms = wave_sum(o * o) * (1.0f / 64.0f);
                const float gr = bf2f(graw[tt]);
                if (!dry || ms == 1.2345e33f) mix[idx] = f2bf(o * __builtin_amdgcn_rsqf(ms + 1e-6f) * hn * gr * sigm(gr));
            }
            __builtin_amdgcn_fence(__ATOMIC_RELEASE, "wavefront");
            __builtin_amdgcn_wave_barrier();
        }
    }
    __syncthreads();
}

__device__ __forceinline__ void rwkv_pre(const Params& p, const Ctx& cx, int l) {
    extern __shared__ __attribute__((aligned(16))) bf16_t shm[];
    float* wl = (float*)shm + (cx.tid >> 6) * 64;
    const int w = cx.tid >> 6, lane = cx.tid & 63, h = w & 3, th = w >> 2, c = h * 64 + lane;
    const bf16_t* proj = (const bf16_t*)(cx.ws + OFF_PH);
    bf16_t* RW = (bf16_t*)(cx.ws + OFF_RW);
    float w2c[32], a2c[32];
#pragma unroll
    for (int j = 0; j < 32; ++j) { w2c[j] = p.in[12 + cx.z][(l * 32 + j) * 256 + c]; a2c[j] = p.in[14 + cx.z][(l * 32 + j) * 256 + c]; }
    const float w0 = p.in[11 + cx.z][l * 256 + c], a0 = p.in[13 + cx.z][l * 256 + c], kkc = p.in[16 + cx.z][l * 256 + c], kac = p.in[17 + cx.z][l * 256 + c];
    const float* mu = p.in[10 + cx.z] + l * 896;
    const float mu_r = mu[c], mu_k = mu[256 + c], mu_v = mu[512 + c], mu_lo = mu[768 + lane];
    for (int tile = cx.bid; tile < 1024; tile += cx.nb) {
        const int tbase = tile * 32 + th * 16;
        bf16_t cr[17], ck[17], cv[17], cl[17];
#pragma unroll
        for (int i = 0; i < 17; ++i) {
            const bf16_t* rp = proj + (size_t)(tbase + i - 1) * DIN + 1792;
            if (i == 0 && (tbase & (SEQ - 1)) == 0) { cr[i] = 0; ck[i] = 0; cv[i] = 0; cl[i] = 0; }
            else { cr[i] = rp[c]; ck[i] = rp[256 + c]; cv[i] = rp[512 + c]; cl[i] = rp[768 + lane]; }
        }
        float Dc = 1.0f;
#pragma unroll
        for (int i = 0; i < 16; ++i) {
            const int t = tbase + i, s = t & (SEQ - 1), b = t >> 13;
            float x0, x1;
            x0 = bf2f(cr[i + 1]); x1 = bf2f(cr[i]); const float r = x0 + mu_r * (x1 - x0);
            x0 = bf2f(ck[i + 1]); x1 = bf2f(ck[i]); const float k = x0 + mu_k * (x1 - x0);
            x0 = bf2f(cv[i + 1]); x1 = bf2f(cv[i]); const float v = x0 + mu_v * (x1 - x0);
            x0 = bf2f(cl[i + 1]); x1 = bf2f(cl[i]); float lo = x0 + mu_lo * (x1 - x0);
            if (lane < 32) lo = 2.0f * sigm(2.0f * lo) - 1.0f;
            f32x2 ws2 = (f32x2){w0, 0.f}, as2 = (f32x2){a0, 0.f};
            wl[lane] = lo;
            __builtin_amdgcn_fence(__ATOMIC_RELEASE, "wavefront");
            __builtin_amdgcn_wave_barrier();
#pragma unroll
            for (int j4 = 0; j4 < 8; ++j4) {
                const f32x4 a4 = *(const f32x4*)(wl + 4 * j4), b4 = *(const f32x4*)(wl + 32 + 4 * j4);
                ws2 += (f32x2){a4[0], a4[1]} * (f32x2){w2c[4 * j4], w2c[4 * j4 + 1]}; ws2 += (f32x2){a4[2], a4[3]} * (f32x2){w2c[4 * j4 + 2], w2c[4 * j4 + 3]};
                as2 += (f32x2){b4[0], b4[1]} * (f32x2){a2c[4 * j4], a2c[4 * j4 + 1]}; as2 += (f32x2){b4[2], b4[3]} * (f32x2){a2c[4 * j4 + 2], a2c[4 * j4 + 3]};
            }
            __builtin_amdgcn_wave_barrier();
            const float wsum = ws2[0] + ws2[1], asum = as2[0] + as2[1];
            const float nx = -wsum;
            const float sp = fmaxf(nx, 0.f) + __logf(1.0f + __expf(-fabsf(nx)));
            const float wpre = -sp - 0.5f;
            const float omw = 1.0f - __expf(-__expf(wpre));
            const float a = sigm(asum);
            const float kkr = k * kkc;
            const float ssq = wave_sum(kkr * kkr);
            const float kk = kkr * fminf(__builtin_amdgcn_rsqf(ssq), 1e12f);
            const float kmod = k * (1.f + (a - 1.f) * kac);
            bf16_t* o = RW + (((size_t)(b * 4 + h) * SEQ + s) * 6) * 64 + lane;
            const float Dp = Dc;
            Dc *= (1.0f - omw);
            const float iD = __builtin_amdgcn_rcpf(Dc);
            o[0] = f2bf(r * Dc); o[64] = f2bf(Dc > 0.5f ? (Dc - 1.0f) : Dc);     o[128] = f2bf(kmod * iD); o[192] = f2bf(-kk * Dp); o[256] = f2bf(kk * a * iD); o[320] = f2bf(v);
        }
    }
    __syncthreads();
}

__device__ __forceinline__ void rwkv_post(const Params& p, const Ctx& cx, int l, bool dry = false) {
    extern __shared__ __attribute__((aligned(16))) bf16_t shm[];
    float* wl = (float*)shm + (cx.tid >> 6) * 64;
    const int w = cx.tid >> 6, lane = cx.tid & 63, h = w & 3, th = w >> 2, c = h * 64 + lane;
    const bf16_t* proj = (const bf16_t*)(cx.ws + OFF_PH);
    const bf16_t* RW = (const bf16_t*)(cx.ws + OFF_RW);
    bf16_t* mix = (bf16_t*)(cx.ws + OFF_MIX);
    float g2c[64];
#pragma unroll
    for (int j = 0; j < 64; ++j) g2c[j] = p.in[15 + cx.z][(l * 64 + j) * 256 + c];
    const float lnw = p.in[19 + cx.z][l * 256 + c], lnb = p.in[20 + cx.z][l * 256 + c], rk = p.in[18 + cx.z][l * 256 + c];
    const float mu_g = p.in[10 + cx.z][l * 896 + 832 + lane];
    for (int tile = cx.bid; tile < 1024; tile += cx.nb) {
        const int tbase = tile * 32 + th * 16;
        bf16_t cg_[17], yr[16], ar[16], ak[16], av[16];
#pragma unroll
        for (int i = 0; i < 17; ++i) {
            if (i == 0 && (tbase & (SEQ - 1)) == 0) cg_[i] = 0;
            else cg_[i] = proj[(size_t)(tbase + i - 1) * DIN + 1792 + 832 + lane];
        }
#pragma unroll
        for (int i = 0; i < 16; ++i) {
            const int t = tbase + i, s = t & (SEQ - 1), b = t >> 13;
            yr[i] = mix[(size_t)t * 1024 + 512 + c];
            const bf16_t* a = RW + (((size_t)(b * 4 + h) * SEQ + s) * 6) * 64 + lane;
            ar[i] = a[0]; ak[i] = a[128]; av[i] = a[320];
        }
#pragma unroll
        for (int i = 0; i < 16; ++i) {
            const int t = tbase + i;
            const float x0 = bf2f(cg_[i + 1]), x1 = bf2f(cg_[i]);
            const float gl = sigm(x0 + mu_g * (x1 - x0));
            f32x2 g2 = (f32x2){0.f, 0.f};
            wl[lane] = gl;
            __builtin_amdgcn_fence(__ATOMIC_RELEASE, "wavefront");
            __builtin_amdgcn_wave_barrier();
#pragma unroll
            for (int j4 = 0; j4 < 16; ++j4) {
                const f32x4 a4 = *(const f32x4*)(wl + 4 * j4);
                g2 += (f32x2){a4[0], a4[1]} * (f32x2){g2c[4 * j4], g2c[4 * j4 + 1]}; g2 += (f32x2){a4[2], a4[3]} * (f32x2){g2c[4 * j4 + 2], g2c[4 * j4 + 3]};
            }
            __builtin_amdgcn_wave_barrier();
            const float g = g2[0] + g2[1];
            const size_t idx = (size_t)t * 1024 + 512 + c;
            const float y = bf2f(yr[i]);
            const float mean = wave_sum(y) * (1.0f / 64.0f);
            const float dlt = y - mean;
            const float var = wave_sum(dlt * dlt) * (1.0f / 64.0f);
            const float yn = dlt * __builtin_amdgcn_rsqf(var + 64e-5f) * lnw + lnb;
            const float r = bf2f(ar[i]), km = bf2f(ak[i]), v = bf2f(av[i]);
            const float bonus = wave_sum(r * km * rk) * v;
            if (!dry || g == 1.2345e33f) mix[idx] = f2bf((yn + bonus) * g);
        }
    }
    __syncthreads();
}

__device__ __forceinline__ void rwkv_scan(const Params& p, const Ctx& cx, int l, int unit) {
    extern __shared__ __attribute__((aligned(16))) bf16_t shm[];
    float* buf = (float*)shm;
    float* ybuf = (float*)shm + 2 * 12288;
    const int tid = cx.tid, lane = tid & 63, wv = tid >> 6;
    const bool scan = tid < 256;
    const int lt = tid - 256;
    const bf16_t* RW = (const bf16_t*)(cx.ws + OFF_RW);
    bf16_t* mix = (bf16_t*)(cx.ws + OFF_MIX);
    const int chain = unit >> 2, qr = unit & 3, b = chain >> 2, h = chain & 3;
    const unsigned* src0 = (const unsigned*)(RW + (size_t)chain * SEQ * 384);
    uint2 pre[24];
    const int grp = lt >> 7, l2 = lt & 127;
    if (!scan) {
        const uint2* s2 = (const uint2*)src0;
        if (grp == 1) {
#pragma unroll
            for (int j = 0; j < 24; ++j) pre[j] = s2[l2 + 128 * j];
#pragma unroll
            for (int j = 0; j < 24; ++j) { const uint2 u = pre[j]; ((float4*)buf)[l2 + 128 * j] = make_float4(__uint_as_float(u.x << 16), __uint_as_float(u.x & 0xffff0000u), __uint_as_float(u.y << 16), __uint_as_float(u.y & 0xffff0000u)); }
#pragma unroll
            for (int j = 0; j < 24; ++j) pre[j] = s2[3072 + l2 + 128 * j];
        } else {
#pragma unroll
            for (int j = 0; j < 24; ++j) pre[j] = s2[2 * 3072 + l2 + 128 * j];
        }
    }
    __syncthreads();
    const int g4 = lane >> 4, q = lane & 15, rloc = wv * 4 + g4, row = qr * 16 + rloc;
    f32x2 s01 = (f32x2){0.f, 0.f}, s23 = (f32x2){0.f, 0.f};
    for (int nb = 0; nb < 256; ++nb) {
        const int cur = nb & 1;
        if (scan) {
            const float* bb = buf + cur * 12288;
            float ysel0 = 0.f, ysel1 = 0.f, yp = 0.f;
            f32x4 r4 = *(const f32x4*)(bb + 4 * q), w4 = *(const f32x4*)(bb + 64 + 4 * q), k4 = *(const f32x4*)(bb + 128 + 4 * q);
            f32x4 kk4 = *(const f32x4*)(bb + 192 + 4 * q), ka4 = *(const f32x4*)(bb + 256 + 4 * q);
            float v = bb[320 + row];
            f32x4 nr4 = *(const f32x4*)(bb + 384 + 4 * q), nw4 = *(const f32x4*)(bb + 384 + 64 + 4 * q), nk4 = *(const f32x4*)(bb + 384 + 128 + 4 * q);
            f32x4 nkk4 = *(const f32x4*)(bb + 384 + 192 + 4 * q), nka4 = *(const f32x4*)(bb + 384 + 256 + 4 * q);
            float nv = bb[384 + 320 + row];
#pragma unroll
            for (int i = 0; i < 32; ++i) {
                f32x4 mr4 = nr4, mw4 = nw4, mk4 = nk4, mkk4 = nkk4, mka4 = nka4; float mv = nv;
                if (i < 30) {
                    const float* tb = bb + (i + 2) * 384;
                    mr4 = *(const f32x4*)(tb + 4 * q); mw4 = *(const f32x4*)(tb + 64 + 4 * q); mk4 = *(const f32x4*)(tb + 128 + 4 * q);
                    mkk4 = *(const f32x4*)(tb + 192 + 4 * q); mka4 = *(const f32x4*)(tb + 256 + 4 * q); mv = tb[320 + row];
                }
                const f32x2 d2 = s01 * (f32x2){kk4[0], kk4[1]} + s23 * (f32x2){kk4[2], kk4[3]};
                float dA = d2[0] + d2[1];
                float yB = yp;
                f32x2 t01, t23;
                dA += dpp_f<0xB1>(dA);  yB += dpp_f<0xB1>(yB);  t01 = s01 + (f32x2){v, v} * (f32x2){k4[0], k4[1]};
                dA += dpp_f<0x4E>(dA);  yB += dpp_f<0x4E>(yB);  t23 = s23 + (f32x2){v, v} * (f32x2){k4[2], k4[3]};
                dA += dpp_f<0x141>(dA); yB += dpp_f<0x141>(yB);
                dA += dpp_f<0x140>(dA); yB += dpp_f<0x140>(yB);
                if (i > 0) { if (i <= 16) ysel0 = (q == i - 1) ? yB : ysel0; else ysel1 = (q == i - 17) ? yB : ysel1; }
                s01 = t01 + (f32x2){dA, dA} * (f32x2){ka4[0], ka4[1]};
                s23 = t23 + (f32x2){dA, dA} * (f32x2){ka4[2], ka4[3]};
                const f32x2 y2 = s01 * (f32x2){r4[0], r4[1]} + s23 * (f32x2){r4[2], r4[3]};
                yp = y2[0] + y2[1];
                if ((i & 15) == 15) {
                    const float d0 = w4[0] < 0.f ? 1.0f + w4[0] : w4[0], d1 = w4[1] < 0.f ? 1.0f + w4[1] : w4[1];
                    const float d2_ = w4[2] < 0.f ? 1.0f + w4[2] : w4[2], d3 = w4[3] < 0.f ? 1.0f + w4[3] : w4[3];
                    s01 = s01 * (f32x2){d0, d1}; s23 = s23 * (f32x2){d2_, d3};
                }
                r4 = nr4; w4 = nw4; k4 = nk4; kk4 = nkk4; ka4 = nka4; v = nv;
                nr4 = mr4; nw4 = mw4; nk4 = mk4; nkk4 = mkk4; nka4 = mka4; nv = mv;
            }
            { const float yl = row16_sum(yp); ysel1 = (q == 15) ? yl : ysel1; }
            ybuf[cur * 512 + q * 16 + rloc] = ysel0;
            ybuf[cur * 512 + (16 + q) * 16 + rloc] = ysel1;
        } else {
            if (grp == ((nb + 1) & 1)) {
                if (nb + 1 < 256) {
                    float4* dst = (float4*)(buf + (cur ^ 1) * 12288);
#pragma unroll
                    for (int j = 0; j < 24; ++j) { const uint2 u = pre[j]; dst[l2 + 128 * j] = make_float4(__uint_as_float(u.x << 16), __uint_as_float(u.x & 0xffff0000u), __uint_as_float(u.y << 16), __uint_as_float(u.y & 0xffff0000u)); }
                }
                if (nb + 3 < 256) {
                    const uint2* src = (const uint2*)src0 + (size_t)(nb + 3) * 3072;
#pragma unroll
                    for (int j = 0; j < 24; ++j) pre[j] = src[l2 + 128 * j];
                }
            }
            if (nb > 0 && lt < 128) {
                const f32x4 yv = *(const f32x4*)(ybuf + (cur ^ 1) * 512 + lt * 4);
                uint2 wv2; wv2.x = pk_bf16(yv[0], yv[1]); wv2.y = pk_bf16(yv[2], yv[3]);
                *(uint2*)(mix + ((size_t)b * SEQ + (nb - 1) * 32 + (lt >> 2)) * 1024 + 512 + h * 64 + qr * 16 + (lt & 3) * 4) = wv2;
            }
        }
        __syncthreads();
    }
    if (!scan && lt < 128) {
        const f32x4 yv = *(const f32x4*)(ybuf + 512 + lt * 4);
        uint2 wv2; wv2.x = pk_bf16(yv[0], yv[1]); wv2.y = pk_bf16(yv[2], yv[3]);
        *(uint2*)(mix + ((size_t)b * SEQ + 255 * 32 + (lt >> 2)) * 1024 + 512 + h * 64 + qr * 16 + (lt & 3) * 4) = wv2;
    }
    __syncthreads();
}

__device__ __forceinline__ void lru_carry_wave(const Ctx& cx, int chain) {
    const float* hend = (const float*)(cx.ws + OFF_SM + SM_HEND);
    const float* ptot = (const float*)(cx.ws + OFF_SM + SM_PTOT);
    float* carry = (float*)(cx.ws + OFF_SM + SM_CARRY);
    const int lane = cx.tid & 63, bb = chain >> 8, e = chain & 255;
    float P[4], H[4];
#pragma unroll
    for (int k = 0; k < 4; ++k) { const int ix = (bb * 256 + lane * 4 + k) * 256 + e; P[k] = ptot[ix]; H[k] = hend[ix]; }
    float A = 1.f, B = 0.f;
#pragma unroll
    for (int k = 0; k < 4; ++k) { B = P[k] * B + H[k]; A = P[k] * A; }
#pragma unroll
    for (int d = 1; d < 64; d <<= 1) {
        const float Ap = __int_as_float(__builtin_amdgcn_ds_bpermute(((lane - d) & 63) << 2, __float_as_int(A)));
        const float Bp = __int_as_float(__builtin_amdgcn_ds_bpermute(((lane - d) & 63) << 2, __float_as_int(B)));
        if (lane >= d) { B = A * Bp + B; A = A * Ap; }
    }
    float x = __int_as_float(__builtin_amdgcn_ds_bpermute(((lane - 1) & 63) << 2, __float_as_int(B)));
    if (lane == 0) x = 0.f;
#pragma unroll
    for (int k = 0; k < 4; ++k) { carry[(bb * 256 + lane * 4 + k) * 256 + e] = x; x = P[k] * x + H[k]; }
}

__device__ __forceinline__ void hgrn_state_scan(const Params& p, const Ctx& cx) {
    float* U = (float*)(cx.ws + OFF_HU);
    const float* dec = (const float*)(cx.ws + OFF_SM + SM_DEC);
    for (int g = cx.bid * 512 + cx.tid; g < 65536; g += cx.nb * 512) {
        const int bh = g >> 12, kv = g & 4095, k = kv >> 6;
        float run = 0.f;
        for (int c0 = 0; c0 < 128; c0 += 16) {
            float u[16], d[16];
#pragma unroll
            for (int j = 0; j < 16; ++j) { const int it = bh * 128 + c0 + j; u[j] = U[(size_t)it * 4096 + kv]; d[j] = dec[it * 64 + k]; }
#pragma unroll
            for (int j = 0; j < 16; ++j) { const int it = bh * 128 + c0 + j; U[(size_t)it * 4096 + kv] = run; run = d[j] * run + u[j]; }
        }
    }
}

__device__ __forceinline__ void lru_m1(const Params& p, const Ctx& cx, int l) {
    extern __shared__ __attribute__((aligned(16))) bf16_t shm[];
    float* conv = (float*)shm;
    const int tid = cx.tid, e = tid & 255, half = tid >> 8, n = e >> 6;
    const bf16_t* proj = (const bf16_t*)(cx.ws + OFF_PH);
    bf16_t* hl = (bf16_t*)cx.out;
    float* Pb = (float*)((char*)cx.out + 16 * MiB);
    float* hend = (float*)(cx.ws + OFF_SM + SM_HEND);
    float* ptot = (float*)(cx.ws + OFF_SM + SM_PTOT);
    float wa[64], wx[64];
#pragma unroll
    for (int d = 0; d < 64; ++d) { wa[d] = p.in[23 + cx.z][((l * 4 + n) * 64 + d) * 64 + (e & 63)]; wx[d] = p.in[25 + cx.z][((l * 4 + n) * 64 + d) * 64 + (e & 63)]; }
    const float cw0 = p.in[21 + cx.z][(l * 4 + 0) * 256 + e], cw1 = p.in[21 + cx.z][(l * 4 + 1) * 256 + e], cw2 = p.in[21 + cx.z][(l * 4 + 2) * 256 + e], cw3 = p.in[21 + cx.z][(l * 4 + 3) * 256 + e];
    const float cb = p.in[22 + cx.z][l * 256 + e], ba = p.in[24 + cx.z][l * 256 + e], bx = p.in[26 + cx.z][l * 256 + e];
    const float lam = p.in[27 + cx.z][l * 256 + e];
    const float spl = log1pf(__expf(-lam));
    for (int item = cx.bid; item < 512; item += cx.nb) {
        const int b = item >> 7, ch = item & 127;
        const int s0 = ch * 64 + half * 32;
        const size_t tb = (size_t)b * SEQ;
        __syncthreads();
        {
            float xm3 = (s0 >= 3) ? bf2f(proj[(tb + s0 - 3) * DIN + 2688 + e]) : 0.f;
            float xm2 = (s0 >= 2) ? bf2f(proj[(tb + s0 - 2) * DIN + 2688 + e]) : 0.f;
            float xm1 = (s0 >= 1) ? bf2f(proj[(tb + s0 - 1) * DIN + 2688 + e]) : 0.f;
            bf16_t xr[32];
#pragma unroll
            for (int tt = 0; tt < 32; ++tt) xr[tt] = proj[(tb + s0 + tt) * DIN + 2688 + e];
#pragma unroll
            for (int tt = 0; tt < 32; ++tt) {
                const float x0 = bf2f(xr[tt]);
                conv[(half * 32 + tt) * 256 + e] = cb + cw0 * xm3 + cw1 * xm2 + cw2 * xm1 + cw3 * x0;
                xm3 = xm2; xm2 = xm1; xm1 = x0;
            }
        }
        __syncthreads();
        float hst = 0.f, P = 1.f;
        for (int tt = 0; tt < 32; ++tt) {
            const int tl = half * 32 + tt;
            const float* cr = conv + tl * 256 + n * 64;
            float ga = ba, gx = bx;
#pragma unroll
            for (int d4 = 0; d4 < 16; ++d4) {
                const f32x4 c4 = *(const f32x4*)(cr + 4 * d4);
                ga += c4[0] * wa[4 * d4] + c4[1] * wa[4 * d4 + 1] + c4[2] * wa[4 * d4 + 2] + c4[3] * wa[4 * d4 + 3];
                gx += c4[0] * wx[4 * d4] + c4[1] * wx[4 * d4 + 1] + c4[2] * wx[4 * d4 + 2] + c4[3] * wx[4 * d4 + 3];
            }
            const float cv = conv[tl * 256 + e];
            const float la = -8.0f * sigm(ga) * spl;
            const float a = __expf(la);
            const float inp = __builtin_amdgcn_sqrtf(fmaxf(1.0f - a * a, 0.f)) * (sigm(gx) * cv);
            hst = a * hst + inp; P *= a;
            const size_t t = tb + s0 + tt;
            hl[t * 256 + e] = f2bf(hst); Pb[t * 256 + e] = P;
        }
        const int sc = ch * 2 + half;
        hend[(b * 256 + sc) * 256 + e] = hst; ptot[(b * 256 + sc) * 256 + e] = P;
    }
    __syncthreads();
}

__device__ __forceinline__ void lru_m3(const Params& p, const Ctx& cx, int l, bool dry = false) {
    const bf16_t* proj = (const bf16_t*)(cx.ws + OFF_PH);
    const bf16_t* hl = (const bf16_t*)cx.out;
    const float* Pb = (const float*)((const char*)cx.out + 16 * MiB);
    const float* carry = (const float*)(cx.ws + OFF_SM + SM_CARRY);
    bf16_t* mix = (bf16_t*)(cx.ws + OFF_MIX);
    const int stride = cx.nb * 512;
    for (int g0 = cx.bid * 512 + cx.tid; g0 < T * 64; g0 += 4 * stride) {
        uint2 hv[4], gv[4]; float4 pv[4], cv[4];
#pragma unroll
        for (int u = 0; u < 4; ++u) {
            const int g = g0 + u * stride;
            if (g < T * 64) {
                const int t = g >> 6, e4 = (g & 63) * 4, b = t >> 13, s_ = t & (SEQ - 1), sc = s_ >> 5;
                hv[u] = *(const uint2*)(hl + (size_t)t * 256 + e4);
                pv[u] = *(const float4*)(Pb + (size_t)t * 256 + e4);
                cv[u] = *(const float4*)(carry + (b * 256 + sc) * 256 + e4);
                gv[u] = *(const uint2*)(proj + (size_t)t * DIN + 2944 + e4);
            }
        }
#pragma unroll
        for (int u = 0; u < 4; ++u) {
            const int g = g0 + u * stride;
            if (g < T * 64) {
                const int t = g >> 6, e4 = (g & 63) * 4;
                float hh[4] = { __uint_as_float(hv[u].x << 16) + pv[u].x * cv[u].x, __uint_as_float(hv[u].x & 0xffff0000u) + pv[u].y * cv[u].y,
                                __uint_as_float(hv[u].y << 16) + pv[u].z * cv[u].z, __uint_as_float(hv[u].y & 0xffff0000u) + pv[u].w * cv[u].w };
                const float gg[4] = { __uint_as_float(gv[u].x << 16), __uint_as_float(gv[u].x & 0xffff0000u), __uint_as_float(gv[u].y << 16), __uint_as_float(gv[u].y & 0xffff0000u) };
#pragma unroll
                for (int j = 0; j < 4; ++j) {
                    const float x = gg[j];
                    hh[j] *= x * sigm(1.5957691216057308f * (x + 0.044715f * x * x * x));
                }
                uint2 wv; wv.x = pk_bf16(hh[0], hh[1]); wv.y = pk_bf16(hh[2], hh[3]);
                *(uint2*)(mix + (size_t)t * 1024 + 768 + e4) = wv;
            }
        }
    }
}

__device__ __forceinline__ void wb_arrive(const Ctx& cx) {
    asm volatile("s_waitcnt vmcnt(0)" ::: "memory");
    __syncthreads();
    if (cx.tid == 0) {
        unsigned* c = (unsigned*)(cx.ws + OFF_SM + SM_CNT);
        __builtin_amdgcn_fence(__ATOMIC_RELEASE, "agent");
        asm volatile("s_waitcnt vmcnt(0)" ::: "memory");
        (void)__hip_atomic_fetch_add(c, 1u, __ATOMIC_RELAXED, __HIP_MEMORY_SCOPE_AGENT);
    }
}
__device__ __forceinline__ void wb_wait(const Ctx& cx, unsigned want) {
    asm volatile("s_waitcnt vmcnt(0)" ::: "memory");
    __syncthreads();
    if (cx.tid == 0) {
        unsigned* c = (unsigned*)(cx.ws + OFF_SM + SM_CNT);
        unsigned spins = 0;
        while (__hip_atomic_load(c, __ATOMIC_RELAXED, __HIP_MEMORY_SCOPE_AGENT) < want) { __builtin_amdgcn_s_sleep(1); if (++spins > (1u << 22)) break; }
        __builtin_amdgcn_fence(__ATOMIC_ACQUIRE, "agent");
        asm volatile("s_waitcnt vmcnt(0)" ::: "memory");
    }
    __syncthreads();
}
__device__ __forceinline__ void phase_mix(const Params& p, const Ctx& cx, int l) {
    if (cx.bid < 64) { rwkv_scan(p, cx, l, cx.bid); }
    else {
        Ctx cw = cx; cw.bid = cx.bid - 64; cw.nb = 192;
        attn_phase(p, cw, l); hgrn_m1(p, cw, l); lru_m1(p, cw, l);
        int tlc = 0;
        wb_arrive(cx);
        if (l < 3) { phase_convw(p, cw, l + 1, tlc, tlc + 1152); tlc += 1152; }
        wb_wait(cx, 192u * (unsigned)(2 * l + 1));
        if (cw.bid < 128) { Ctx cs = cw; cs.nb = 128; hgrn_state_scan(p, cs); }
        else { const int c0 = (cw.bid - 128) * 16 + (cx.tid >> 6) * 2; lru_carry_wave(cx, c0); lru_carry_wave(cx, c0 + 1); }
        wb_arrive(cx);
        if (l < 3) { phase_convw(p, cw, l + 1, tlc, tlc + 1152); tlc += 1152; }
        wb_wait(cx, 192u * (unsigned)(2 * l + 2));
        hgrn_m3(p, cw, l); lru_m3(p, cw, l);
        if (l < 3) phase_convw(p, cw, l + 1, tlc, 3136);
    }
}

constexpr int PPL = 9;
constexpr int N_PHASES = 1 + 4 * PPL;
__device__ __forceinline__ void run_phase(const Params& p, const Ctx& cx, int ph) {
    const bf16_t* xb = (const bf16_t*)(cx.ws + OFF_XB);
    const float* rinv = (const float*)(cx.ws + OFF_SM + SM_RINV);
    const bf16_t* gA = nullptr; const bf16_t* gB = nullptr; bf16_t* gO = nullptr; int gN = 0, gK = 0, gld = 0, gncv = 0, gepi = -1;
    if (ph == 0) { phase_row(p, cx, 0, 0); phase_convw(p, cx, 0); phase_lb(p, cx); }
    else {
        const int l = (ph - 1) / PPL, k = (ph - 1) % PPL;
        switch (k) {
        case 0: gA = xb; gB = (const bf16_t*)(wbase(cx, l) + OFF_WIN); gO = (bf16_t*)(cx.ws + OFF_PH); gN = DINP; gK = 1024; gld = DIN; gncv = DIN; gepi = EPI_PROJ; break;
        case 1: rwkv_pre(p, cx, l); break;
        case 2: phase_mix(p, cx, l); break;
        case 3: rwkv_post(p, cx, l); break;
        case 4: gA = (const bf16_t*)(cx.ws + OFF_MIX); gB = (const bf16_t*)(wbase(cx, l) + OFF_WOUT); gO = (bf16_t*)(cx.ws + OFF_PH); gN = 1024; gK = 1024; gld = 1024; gncv = 1024; gepi = EPI_FF; break;
        case 5: phase_row(p, cx, 1, l); break;
        case 6: gA = xb; gB = (const bf16_t*)(wbase(cx, l) + OFF_W1); gO = (bf16_t*)(cx.ws + OFF_PH); gN = 4096; gK = 1024; gld = 4096; gncv = 4096; gepi = EPI_UP; break;
        case 7: gA = (const bf16_t*)(cx.ws + OFF_PH); gB = (const bf16_t*)(wbase(cx, l) + OFF_W2); gO = (bf16_t*)(cx.ws + OFF_MIX); gN = 1024; gK = 4096; gld = 1024; gncv = 1024; gepi = EPI_FF; break;
        case 8: phase_row(p, cx, 2, l); break;
        }
    }
    if (gepi >= 0) gemm_phase(cx, gepi, gA, gB, T, gN, gK, gO, gld, gncv, rinv);
}

__global__ void __launch_bounds__(512, 2) fwd_kernel(Params p, int ph_lo, int ph_hi) {
    extern __shared__ __attribute__((aligned(16))) bf16_t shm[];
    cg::grid_group grid = cg::this_grid();
    volatile LAS unsigned* st = (volatile LAS unsigned*)((LAS char*)shm + 131072);
    if (threadIdx.x == 0) { st[0] = 0u; st[1] = 0u; }
    __syncthreads();
    XcdBarrier xb = xcd_barrier_post((unsigned*)(p.ws + OFF_SM + SM_BAR), st);
    for (int ph = ph_lo; ph < ph_hi; ++ph) {
        Ctx cx;
        cx.tid = threadIdx.x; cx.bid = blockIdx.x; cx.nb = gridDim.x; cx.ws = p.ws; cx.out = p.out; cx.z = 0;
        asm volatile("" : "+v"(cx.tid));
        asm volatile("" : "+s"(cx.bid), "+s"(cx.nb), "+s"(cx.ws), "+s"(cx.out), "+s"(cx.z));
        run_phase(p, cx, ph);
        if (ph + 1 < ph_hi) { if (ph == ph_lo) grid.sync(); else xcd_barrier(xb); }
    }
}

extern "C" void kernel_launch(void* const* d_in, const int* in_sizes, int n_in, void* d_out, int out_size, void* d_ws, size_t ws_size, hipStream_t stream) {
    static int grid_blocks = 0;
    if (!grid_blocks) {
        int dev = 0, cus = 0, per_cu = 0;
        (void)hipGetDevice(&dev);
        (void)hipDeviceGetAttribute(&cus, hipDeviceAttributeMultiprocessorCount, dev);
        (void)hipFuncSetAttribute((const void*)fwd_kernel, hipFuncAttributeMaxDynamicSharedMemorySize, LDS_BYTES);
        (void)hipOccupancyMaxActiveBlocksPerMultiprocessor(&per_cu, (const void*)fwd_kernel, 512, LDS_BYTES);
        if (per_cu < 1) per_cu = 1;
        grid_blocks = cus * per_cu;
        if (grid_blocks > 256) grid_blocks = 256;
        if (ws_size < 510 * MiB) fprintf(stderr, "kernel_launch: workspace too small: %zu\n", ws_size);
    }
    (void)hipMemsetAsync((char*)d_ws + OFF_SM + SM_BAR, 0, 16384 + 256, stream);
    Params p{};
    for (int i = 0; i < 30; ++i) p.in[i] = (const float*)d_in[i];
    p.out = (float*)d_out; p.ws = (char*)d_ws;
#if MEGA
    int lo = 0, hi = N_PHASES;
    void* args[] = {&p, &lo, &hi};
    hipError_t e = hipLaunchCooperativeKernel((const void*)fwd_kernel, dim3(grid_blocks), dim3(512), args, LDS_BYTES, stream);
    if (e != hipSuccess) fprintf(stderr, "cooperative launch failed: %s (grid %d)\n", hipGetErrorString(e), grid_blocks);
#else
    for (int ph = 0; ph < N_PHASES; ++ph) hipLaunchKernelGGL(fwd_kernel, dim3(grid_blocks), dim3(512), LDS_BYTES, stream, p, ph, ph + 1);
#endif
}
```

```cpp
#include <hip/hip_runtime.h>
#include <hip/hip_cooperative_groups.h>
#include <cstdio>
namespace cg = cooperative_groups;

#ifndef MEGA
#define MEGA 1
#endif
#ifndef DUP
#define DUP 0
#endif

typedef unsigned short bf16_t;
typedef short bf16x8 __attribute__((ext_vector_type(8)));
typedef short bf16x4 __attribute__((ext_vector_type(4)));
typedef float f32x4 __attribute__((ext_vector_type(4)));
typedef float f32x2 __attribute__((ext_vector_type(2)));

constexpr int T = 32768, SEQ = 8192, DIN = 3200, DINP = 3328;
constexpr size_t MiB = 1u << 20;
constexpr size_t OFF_WIN = 0;
constexpr size_t OFF_WOUT = OFF_WIN + (size_t)DINP * 1024 * 2;
constexpr size_t OFF_W1 = OFF_WOUT + (size_t)1024 * 1024 * 2;
constexpr size_t OFF_W2 = OFF_W1 + (size_t)4096 * 1024 * 2;
constexpr size_t OFF_PH = 26 * MiB;
constexpr size_t OFF_HU = OFF_PH + 200 * MiB;
constexpr size_t OFF_MIX = OFF_PH + 256 * MiB;
constexpr size_t OFF_XB = OFF_MIX + 64 * MiB;
constexpr size_t OFF_LP = OFF_XB + 16 * MiB;
constexpr size_t OFF_RW = OFF_XB + 64 * MiB;
constexpr size_t OFF_SM = OFF_RW + 96 * MiB;
constexpr size_t SM_RINV = 0, SM_LB = 128 * 1024, SM_DEC = 256 * 1024, SM_HEND = 1 * MiB, SM_PTOT = 2 * MiB, SM_CARRY = 3 * MiB;
constexpr int LDS_BYTES = 131072 + 16;
constexpr size_t SM_BAR = 4 * MiB, SM_CNT = 4 * MiB + 16384;

struct Params { const float* in[30]; float* out; char* ws; };
struct Ctx { int tid, bid, nb, z; char* ws; float* out; };
__device__ __forceinline__ char* wbase(const Ctx& cx, int l) { return (l & 1) ? ((char*)cx.out + 80 * (size_t)(1u << 20)) : cx.ws; }

__device__ __forceinline__ float bf2f(bf16_t h) { return __uint_as_float(((unsigned)h) << 16); }
__device__ __forceinline__ unsigned pk_bf16(float lo, float hi) { unsigned r; asm("v_cvt_pk_bf16_f32 %0, %1, %2" : "=v"(r) : "v"(lo), "v"(hi)); return r; }
__device__ __forceinline__ bf16_t f2bf(float f) { return (bf16_t)(pk_bf16(f, 0.f) & 0xffffu); }
__device__ __forceinline__ float shx(float v, int lane, int m) { return __int_as_float(__builtin_amdgcn_ds_bpermute((lane ^ m) << 2, __float_as_int(v))); }
template <int CTRL> __device__ __forceinline__ float dpp_f(float x) { return __int_as_float(__builtin_amdgcn_update_dpp(0, __float_as_int(x), CTRL, 0xF, 0xF, true)); }
__device__ __forceinline__ float row16_sum(float x) {
    x += dpp_f<0xB1>(x);
    x += dpp_f<0x4E>(x);
    x += dpp_f<0x141>(x);
    x += dpp_f<0x140>(x);
    return x;
}
__device__ __forceinline__ float rdlane(float v, int l) { return __int_as_float(__builtin_amdgcn_readlane(__float_as_int(v), l)); }
__device__ __forceinline__ float wave_sum(float v) {
    v = row16_sum(v);
    return (rdlane(v, 0) + rdlane(v, 16)) + (rdlane(v, 32) + rdlane(v, 48));
}
__device__ __forceinline__ float sigm(float x) { return __builtin_amdgcn_rcpf(1.0f + __expf(-x)); }


#define XB_TMO      128
#define XB_XCNT(j)  (256  + 64 * (j))
#define XB_XSUB(j)  (1280 + 64 * (j))
#define XB_XGEN(j)  (2304 + 64 * (j))
#define XB_TOP      3328
#define XB_TOPGEN   3392
#define XCD_BAR_WORDS 3456
#define XB_SPIN_CAP (1u << 18)
#define LAS __attribute__((address_space(3)))
__device__ __forceinline__ unsigned xb_ld(unsigned* p)              { return __hip_atomic_load(p, __ATOMIC_RELAXED, __HIP_MEMORY_SCOPE_AGENT); }
__device__ __forceinline__ unsigned xb_add(unsigned* p, unsigned v) { return __hip_atomic_fetch_add(p, v, __ATOMIC_RELAXED, __HIP_MEMORY_SCOPE_AGENT); }
__device__ __forceinline__ unsigned xb_xcc_id() { return (unsigned)__builtin_amdgcn_s_getreg((3 << 11) | 20) & 0xFu; }
#define XB_SPIN(cond, bar) do { unsigned _sp = 0; while (cond) { __builtin_amdgcn_s_sleep(1); \
    if ((++_sp & 255u) == 0u) { if (xb_ld(&(bar)[XB_TMO])) break; if (_sp > XB_SPIN_CAP) { atomicAdd(&(bar)[XB_TMO], 1u); break; } } } } while (0)
struct XcdBarrier { unsigned* bar; unsigned x; volatile LAS unsigned* st; };
__device__ __forceinline__ XcdBarrier xcd_barrier_post(unsigned* bar, volatile LAS unsigned* st) {
    XcdBarrier b; b.bar = bar; b.x = xb_xcc_id(); b.st = st;
    if (threadIdx.x == 0) (void)xb_add(&bar[XB_XCNT(b.x)], 1u);
    return b;
}
__device__ __forceinline__ void xcd_barrier_complete(unsigned* bar, unsigned x, unsigned& nloc, unsigned& nx) {
    const unsigned G = gridDim.x * gridDim.y * gridDim.z;
    unsigned sum, cnt, mine, sp = 0u;
    for (;;) {
        sum = 0u; cnt = 0u; mine = 0u;
#pragma unroll
        for (unsigned j = 0; j < 16; ++j) { const unsigned c = xb_ld(&bar[XB_XCNT(j)]); sum += c; cnt += (c > 0u) ? 1u : 0u; mine = (j == x) ? c : mine; }
        if (sum == G) break;
        __builtin_amdgcn_s_sleep(1);
        if ((++sp & 255u) == 0u) { if (xb_ld(&bar[XB_TMO])) break; if (sp > XB_SPIN_CAP) { atomicAdd(&bar[XB_TMO], 1u); break; } }
    }
    nloc = mine > 0u ? mine : 1u; nx = cnt > 0u ? cnt : 1u;
}
__device__ __forceinline__ void xcd_barrier(const XcdBarrier& b) {
    asm volatile("s_waitcnt vmcnt(0)" ::: "memory");
    __syncthreads();
    if (threadIdx.x == 0) {
        unsigned* bar = b.bar;
        __builtin_amdgcn_s_waitcnt(0);
        unsigned nloc = b.st[0], nx = b.st[1];
        if (nloc == 0u) { xcd_barrier_complete(bar, b.x, nloc, nx); b.st[0] = nloc; b.st[1] = nx; }
        const unsigned old = xb_add(&bar[XB_XSUB(b.x)], 1u);
        const unsigned gen = old / nloc;
        if (old + 1u == (gen + 1u) * nloc) {
            __builtin_amdgcn_fence(__ATOMIC_RELEASE, "agent");
            asm volatile("s_waitcnt vmcnt(0)" ::: "memory");
            const unsigned og = xb_add(&bar[XB_TOP], 1u);
            const unsigned tg = og / nx;
            if (og + 1u == (tg + 1u) * nx) xb_add(&bar[XB_TOPGEN], 1u);
            else XB_SPIN(xb_ld(&bar[XB_TOPGEN]) == tg, bar);
            __builtin_amdgcn_fence(__ATOMIC_ACQUIRE, "agent");
            xb_add(&bar[XB_XGEN(b.x)], 1u);
            asm volatile("s_waitcnt vmcnt(0)" ::: "memory");
        } else {
            XB_SPIN(xb_ld(&bar[XB_XGEN(b.x)]) == gen, bar);
            __builtin_amdgcn_fence(__ATOMIC_ACQUIRE, "agent");
            asm volatile("s_waitcnt vmcnt(0)" ::: "memory");
        }
    }
    __syncthreads();
}

constexpr int BM = 256, BK = 64, HALF = 128, HT = HALF * BK, NXCD = 8, WGM = 8;
__device__ __forceinline__ int lds_byte(int r, int c) {
    int st = (r >> 4) * 2 + (c >> 5), rr = r & 15, cc = c & 31, ob = rr * 64 + cc * 2;
    return st * 1024 + (ob ^ (((ob >> 9) & 1) << 5));
}
__device__ __forceinline__ void stage_rc(int b, int& R, int& C) {
    int st = b / 1024, sb = b % 1024, swz = sb ^ (((sb >> 9) & 1) << 5);
    R = (st >> 1) * 16 + swz / 64; C = (st & 1) * 32 + (swz % 64) / 2;
}
enum { EPI_PROJ = 0, EPI_FF = 1, EPI_UP = 2 };

__device__ __forceinline__ void gemm_tile(const Ctx& cx, const int EPI, const bf16_t* __restrict__ A, const bf16_t* __restrict__ Bt, const int K, const int brow, const int bcol,
                                          bf16_t* __restrict__ O, const int ldo, const int ncv, const float* __restrict__ rinv) {
    extern __shared__ __attribute__((aligned(16))) bf16_t shm[];
#define SA(b, h) (shm + ((b) * 2 + (h)) * HT)
#define SB(b, h) (shm + (4 + (b) * 2 + (h)) * HT)
#define STAGE(P, BASE, br, kt) do { const char* _ub = (const char*)(BASE) + ((size_t)(br) * (size_t)K + (size_t)(kt) * BK) * 2; \
    for (int _i = 0; _i < 2; ++_i) { unsigned _o = roff[_i]; asm volatile("" : "+v"(_o)); \
      __builtin_amdgcn_global_load_lds((const unsigned*)(_ub + _o), (unsigned*)((char*)(P) + cx.tid * 16 + _i * 8192), 16, 0, 0); } } while (0)
#define LDA(dst, b, h) for (int m = 0; m < 4; ++m) for (int k = 0; k < 2; ++k) \
    dst[m][k] = *reinterpret_cast<const bf16x8*>((char*)SA(b, h) + lds_byte(wr * 64 + m * 16 + fr, k * 32 + fq * 8))
#define LDB(dst, b, h) for (int n = 0; n < 2; ++n) for (int k = 0; k < 2; ++k) \
    dst[n][k] = *reinterpret_cast<const bf16x8*>((char*)SB(b, h) + lds_byte(wc * 32 + n * 16 + fr, k * 32 + fq * 8))
#define MMA(ai, bj, At_, Bt_) do { __builtin_amdgcn_s_setprio(1); \
    for (int m = 0; m < 4; ++m) for (int n = 0; n < 2; ++n) for (int k = 0; k < 2; ++k) \
      acc[ai][bj][m][n] = __builtin_amdgcn_mfma_f32_16x16x32_bf16(Bt_[n][k], At_[m][k], acc[ai][bj][m][n], 0, 0, 0); \
    __builtin_amdgcn_s_setprio(0); } while (0)
#define WAIT_V(n) asm volatile("s_waitcnt vmcnt(" #n ")" ::: "memory")
#define WAIT_L(n) asm volatile("s_waitcnt lgkmcnt(" #n ")" ::: "memory")
#define BAR __builtin_amdgcn_s_barrier()
#define SCHED __builtin_amdgcn_sched_barrier(0)
    const int wid = cx.tid >> 6, lane = cx.tid & 63, wr = wid >> 2, wc = wid & 3, fr = lane & 15, fq = lane >> 4;
    f32x4 acc[2][2][4][2] = {};
    bf16x8 At[4][2], B0[2][2], B1[2][2];
    const int nt = K / BK;
    unsigned roff[2];
#pragma unroll
    for (int _i = 0; _i < 2; ++_i) { int _r, _c; stage_rc(cx.tid * 16 + _i * 8192, _r, _c); roff[_i] = (unsigned)(_r * K + _c) * 2u; }
    STAGE(SB(0, 0), Bt, bcol, 0); STAGE(SA(0, 0), A, brow, 0);
    STAGE(SB(0, 1), Bt, bcol + HALF, 0); STAGE(SA(0, 1), A, brow + HALF, 0);
    if (wr == 1) BAR;
    WAIT_V(4); BAR;
    STAGE(SB(1, 0), Bt, bcol, 1); STAGE(SA(1, 0), A, brow, 1); STAGE(SB(1, 1), Bt, bcol + HALF, 1);
    WAIT_V(6); BAR;
    for (int t = 0; t < nt - 2; t += 2) {
        LDB(B0, 0, 0); SCHED; LDA(At, 0, 0); STAGE(SA(1, 1), A, brow + HALF, t + 1);
        WAIT_L(8); BAR; WAIT_L(0); MMA(0, 0, At, B0); BAR; SCHED;
        LDB(B1, 0, 1); STAGE(SB(0, 0), Bt, bcol, t + 2);
        BAR; WAIT_L(0); MMA(0, 1, At, B1); BAR;
        LDA(At, 0, 1); STAGE(SA(0, 0), A, brow, t + 2);
        BAR; WAIT_L(0); MMA(1, 0, At, B0); BAR; SCHED;
        STAGE(SB(0, 1), Bt, bcol + HALF, t + 2);
        WAIT_V(6); BAR; MMA(1, 1, At, B1); BAR;
        LDB(B0, 1, 0); SCHED; LDA(At, 1, 0); STAGE(SA(0, 1), A, brow + HALF, t + 2);
        WAIT_L(8); BAR; WAIT_L(0); MMA(0, 0, At, B0); BAR; SCHED;
        LDB(B1, 1, 1); STAGE(SB(1, 0), Bt, bcol, t + 3);
        BAR; WAIT_L(0); MMA(0, 1, At, B1); BAR;
        LDA(At, 1, 1); STAGE(SA(1, 0), A, brow, t + 3);
        BAR; WAIT_L(0); MMA(1, 0, At, B0); BAR; SCHED;
        STAGE(SB(1, 1), Bt, bcol + HALF, t + 3);
        WAIT_V(6); BAR; MMA(1, 1, At, B1); BAR;
    }
    { LDB(B0, 0, 0); LDA(At, 0, 0); STAGE(SA(1, 1), A, brow + HALF, nt - 1);
      BAR; WAIT_L(0); MMA(0, 0, At, B0); BAR;
      LDB(B1, 0, 1); BAR; WAIT_L(0); MMA(0, 1, At, B1); BAR;
      LDA(At, 0, 1); WAIT_V(4); BAR; WAIT_L(0); MMA(1, 0, At, B0); MMA(1, 1, At, B1); BAR; }
    { LDB(B0, 1, 0); LDA(At, 1, 0); WAIT_V(2); BAR; WAIT_L(0); MMA(0, 0, At, B0); BAR;
      LDB(B1, 1, 1); WAIT_V(0); BAR; WAIT_L(0); MMA(0, 1, At, B1); BAR;
      LDA(At, 1, 1); BAR; WAIT_L(0); MMA(1, 0, At, B0); MMA(1, 1, At, B1); BAR; }
    if (wr == 0) BAR;
#pragma unroll
    for (int ai = 0; ai < 2; ++ai)
#pragma unroll
        for (int m = 0; m < 4; ++m) {
            const int row = brow + ai * HALF + wr * 64 + m * 16 + fr;
            float rs = 1.0f;
            if (EPI != EPI_FF) rs = rinv[row];
            bf16_t* orow = O + (size_t)row * ldo;
#pragma unroll
            for (int bj = 0; bj < 2; ++bj)
#pragma unroll
                for (int n = 0; n < 2; ++n) {
                    const int col = bcol + bj * HALF + wc * 32 + n * 16 + fq * 4;
                    f32x4 v = acc[ai][bj][m][n];
                    if (EPI != EPI_FF) v *= rs;
                    if (EPI == EPI_UP) {
#pragma unroll
                        for (int j = 0; j < 4; ++j) { float r = fmaxf(v[j], 0.f); v[j] = r * r; }
                    }
                    if (col < ncv) { uint2 w; w.x = pk_bf16(v[0], v[1]); w.y = pk_bf16(v[2], v[3]); *(uint2*)(orow + col) = w; }
                }
        }
#undef SA
#undef SB
#undef STAGE
#undef LDA
#undef LDB
#undef MMA
}

__device__ __forceinline__ void gemm_phase(const Ctx& cx, const int EPI, const bf16_t* A, const bf16_t* Bt, int M, int N, int K, bf16_t* O, int ldo, int ncv, const float* rinv) {
    const int nM = M / BM, nN = N / BM, nwg = nM * nN;
    for (int i = 0;; ++i) {
        const long L = (long)i * cx.nb + cx.bid;
        if (L >= nwg) break;
        int wgid = (int)L;
        { const int q = nwg / NXCD, r = nwg % NXCD, xcd = wgid % NXCD, off = wgid / NXCD; wgid = (xcd < r ? xcd * (q + 1) : r * (q + 1) + (xcd - r) * q) + off; }
        const int nig = WGM * nN, gid = wgid / nig, fm = gid * WGM, gsz = (nM - fm) < WGM ? (nM - fm) : WGM;
        const int pm = fm + ((wgid % nig) % gsz), pn = (wgid % nig) / gsz;
        gemm_tile(cx, EPI, A, Bt, K, pm * BM, pn * BM, O, ldo, ncv, rinv);
        __syncthreads();
    }
}

template <int NR>
__device__ __forceinline__ void rows_do(const Params& p, const Ctx& cx, int mode, int l, int row0) {
    const bf16_t* ff = (const bf16_t*)(cx.ws + (mode == 1 ? OFF_PH : OFF_MIX));
    const float* gain = (mode == 1 ? p.in[2 + cx.z] : p.in[4 + cx.z]) + l * 1024;
    bf16_t* xb = (bf16_t*)(cx.ws + OFF_XB);
    float* rinv = (float*)(cx.ws + OFF_SM + SM_RINV);
    const int lane = cx.tid & 63;
    const bool fin = (mode == 2 && l == 3);
    float4 xv[NR][4];
    uint2 fu[NR][4];
#pragma unroll
    for (int r = 0; r < NR; ++r) {
        const size_t row = (size_t)(row0 + r);
#pragma unroll
        for (int i = 0; i < 4; ++i) {
            if (mode == 0) xv[r][i] = ((const float4*)(p.in[0 + cx.z] + row * 1024))[i * 64 + lane];
            else {
                const uint2 u = ((const uint2*)(xb + row * 1024))[i * 64 + lane];
                xv[r][i].x = __uint_as_float(u.x << 16); xv[r][i].y = __uint_as_float(u.x & 0xffff0000u);
                xv[r][i].z = __uint_as_float(u.y << 16); xv[r][i].w = __uint_as_float(u.y & 0xffff0000u);
                fu[r][i] = ((const uint2*)(ff + row * 1024))[i * 64 + lane];
            }
        }
    }
#pragma unroll
    for (int r = 0; r < NR; ++r) {
        const size_t row = (size_t)(row0 + r);
        if (mode) {
            float fv[4][4]; float ss = 0.f;
#pragma unroll
            for (int i = 0; i < 4; ++i) {
                const uint2 u = fu[r][i];
                fv[i][0] = __uint_as_float(u.x << 16); fv[i][1] = __uint_as_float(u.x & 0xffff0000u);
                fv[i][2] = __uint_as_float(u.y << 16); fv[i][3] = __uint_as_float(u.y & 0xffff0000u);
                ss += fv[i][0] * fv[i][0] + fv[i][1] * fv[i][1] + fv[i][2] * fv[i][2] + fv[i][3] * fv[i][3];
            }
            ss = wave_sum(ss);
            const float sc = rsqrtf(ss * (1.0f / 1024.0f) + 1e-6f);
#pragma unroll
            for (int i = 0; i < 4; ++i) {
                const float4 g = ((const float4*)gain)[i * 64 + lane];
                xv[r][i].x += fv[i][0] * sc * g.x; xv[r][i].y += fv[i][1] * sc * g.y; xv[r][i].z += fv[i][2] * sc * g.z; xv[r][i].w += fv[i][3] * sc * g.w;
            }
        }
        if (fin) {
#pragma unroll
            for (int i = 0; i < 4; ++i) ((float4*)(cx.out + row * 1024))[i * 64 + lane] = xv[r][i];
        } else {
            float s2 = 0.f;
#pragma unroll
            for (int i = 0; i < 4; ++i) s2 += xv[r][i].x * xv[r][i].x + xv[r][i].y * xv[r][i].y + xv[r][i].z * xv[r][i].z + xv[r][i].w * xv[r][i].w;
            s2 = wave_sum(s2);
            if (lane == 0) rinv[row] = rsqrtf(s2 * (1.0f / 1024.0f) + 1e-6f);
#pragma unroll
            for (int i = 0; i < 4; ++i) {
                uint2 w; w.x = pk_bf16(xv[r][i].x, xv[r][i].y); w.y = pk_bf16(xv[r][i].z, xv[r][i].w);
                ((uint2*)(xb + row * 1024))[i * 64 + lane] = w;
            }
        }
    }
}
__device__ __forceinline__ void phase_row(const Params& p, const Ctx& cx, int mode, int l, bool dry = false) {
    const int wave = cx.tid >> 6;
    for (int row = (cx.bid * 8 + wave) * 4; row < T; row += cx.nb * 8 * 4) rows_do<4>(p, cx, mode, l, row);
}

__device__ __forceinline__ void phase_convw(const Params& p, const Ctx& cx, int l, int tl0 = 0, int tl1 = 3136) {
    extern __shared__ __attribute__((aligned(16))) bf16_t shm[];
    float* tile = (float*)shm;
    const int tid = cx.tid;
    char* wb_ = wbase(cx, l);
    for (int tl = tl0 + cx.bid; tl < tl1; tl += cx.nb) {
        const float* W; const float* g; bf16_t* Wt; int K, N, nNt, loc;
        if (tl < 832) { W = p.in[5 + cx.z] + (size_t)l * 1024 * 3200; g = p.in[1 + cx.z] + l * 1024; Wt = (bf16_t*)(wb_ + OFF_WIN); K = 1024; N = 3200; nNt = 52; loc = tl; }
        else if (tl < 1088) { W = p.in[6 + cx.z] + (size_t)l * 1024 * 1024; g = nullptr; Wt = (bf16_t*)(wb_ + OFF_WOUT); K = 1024; N = 1024; nNt = 16; loc = tl - 832; }
        else if (tl < 2112) { W = p.in[28 + cx.z] + (size_t)l * 1024 * 4096; g = p.in[3 + cx.z] + l * 1024; Wt = (bf16_t*)(wb_ + OFF_W1); K = 1024; N = 4096; nNt = 64; loc = tl - 1088; }
        else { W = p.in[29 + cx.z] + (size_t)l * 4096 * 1024; g = nullptr; Wt = (bf16_t*)(wb_ + OFF_W2); K = 4096; N = 1024; nNt = 16; loc = tl - 2112; }
        const int k0 = (loc / nNt) * 64, n0 = (loc % nNt) * 64;
#pragma unroll
        for (int i = 0; i < 8; ++i) {
            const int k = i * 8 + (tid >> 6), n = tid & 63;
            float v = 0.f;
            if (n0 + n < N) { v = W[(size_t)(k0 + k) * N + n0 + n]; if (g) v *= g[k0 + k]; }
            tile[k * 65 + n] = v;
        }
        __syncthreads();
#pragma unroll
        for (int i = 0; i < 4; ++i) {
            const int n = i * 16 + (tid >> 5), k = (tid & 31) * 2;
            *(unsigned*)(Wt + (size_t)(n0 + n) * K + k0 + k) = pk_bf16(tile[k * 65 + n], tile[(k + 1) * 65 + n]);
        }
        __syncthreads();
    }
}

__device__ __forceinline__ void phase_lb(const Params& p, const Ctx& cx) {
    if (cx.bid == 0 && cx.tid < 256) {
        const int c = cx.tid;
        float v[4], mx = -1e30f;
        for (int l = 0; l < 4; ++l) { v[l] = p.in[8 + cx.z][l * 256 + c]; mx = fmaxf(mx, v[l]); }
        float s = 0.f;
        for (int l = 0; l < 4; ++l) { v[l] = expf(v[l] - mx); s += v[l]; }
        float* lb = (float*)(cx.ws + OFF_SM + SM_LB);
        float cum = 0.f;
        for (int l = 0; l < 4; ++l) { if (l > 0) cum += v[l] / s; lb[l * 256 + c] = fmaxf(cum, 0.f); }
    }
}

__device__ __forceinline__ void attn_phase(const Params& p, const Ctx& cx, int l) {
    extern __shared__ __attribute__((aligned(16))) bf16_t shm[];
    bf16_t* vT = shm;
    float* sb = (float*)((char*)shm + 69632);
    const bf16_t* proj = (const bf16_t*)(cx.ws + OFF_PH);
    bf16_t* mix = (bf16_t*)(cx.ws + OFF_MIX);
    const int tid = cx.tid, w = tid >> 6, lane = tid & 63, fr = lane & 15, fq = lane >> 4;
    const int h = w >> 1, qh = w & 1;
    for (int i = tid; i < 2052; i += 512) sb[i] = p.in[7 + cx.z][l * 2052 + i];
    const float* sbh = sb + h * 513;
    for (int item = cx.bid; item < 512; item += cx.nb) {
        const int b = item >> 7, c = item & 127;
        const size_t tq = (size_t)b * SEQ + c * 64;
        bf16x8 Qf[2][2];
#pragma unroll
        for (int qt = 0; qt < 2; ++qt)
#pragma unroll
            for (int ks = 0; ks < 2; ++ks)
                Qf[qt][ks] = *(const bf16x8*)(proj + (tq + qh * 32 + qt * 16 + fr) * DIN + h * 64 + ks * 32 + fq * 8);
        f32x4 O[4][2];
#pragma unroll
        for (int dt = 0; dt < 4; ++dt) { O[dt][0] = (f32x4){0.f, 0.f, 0.f, 0.f}; O[dt][1] = (f32x4){0.f, 0.f, 0.f, 0.f}; }
        float mrun[2] = {-1e30f, -1e30f}, lsum[2] = {0.f, 0.f};
        const int j0 = (8 - c) > 0 ? (8 - c) : 0;
        auto stage = [&](int j, int buf) {
            const size_t tk = (size_t)b * SEQ + (size_t)(c - 8 + j) * 64;
#pragma unroll
            for (int i = 0; i < 4; ++i) {
                const int idx = i * 512 + tid, key = idx & 63, cgp = idx >> 6;
                const bf16x8 v = *(const bf16x8*)(proj + (tk + key) * DIN + 512 + cgp * 8);
                const int hd = cgp >> 3, d0 = (cgp & 7) * 8;
#pragma unroll
                for (int jj = 0; jj < 8; ++jj) vT[((buf * 4 + hd) * 64 + d0 + jj) * 68 + key] = (bf16_t)v[jj];
            }
        };
        __syncthreads();
        stage(j0, 0);
        bf16x8 Kc[4][2];
        {
            const size_t tk0 = (size_t)b * SEQ + (size_t)(c - 8 + j0) * 64;
#pragma unroll
            for (int kt = 0; kt < 4; ++kt) {
                Kc[kt][0] = *(const bf16x8*)(proj + (tk0 + kt * 16 + fr) * DIN + 256 + h * 64 + fq * 8);
                Kc[kt][1] = *(const bf16x8*)(proj + (tk0 + kt * 16 + fr) * DIN + 256 + h * 64 + 32 + fq * 8);
            }
        }
        __syncthreads();
        for (int j = j0; j <= 8; ++j) {
            const int cur = (j - j0) & 1;
            if (j < 8) stage(j + 1, cur ^ 1);
            const size_t tk = (size_t)b * SEQ + (size_t)(c - 8 + j) * 64;
            f32x4 S[4][2];
#pragma unroll
            for (int kt = 0; kt < 4; ++kt) {
#pragma unroll
                for (int qt = 0; qt < 2; ++qt) {
                    f32x4 a = (f32x4){0.f, 0.f, 0.f, 0.f};
                    a = __builtin_amdgcn_mfma_f32_16x16x32_bf16(Kc[kt][0], Qf[qt][0], a, 0, 0, 0);
                    a = __builtin_amdgcn_mfma_f32_16x16x32_bf16(Kc[kt][1], Qf[qt][1], a, 0, 0, 0);
                    S[kt][qt] = a;
                }
            }
            if (j < 8) {
#pragma unroll
                for (int kt = 0; kt < 4; ++kt) {
                    Kc[kt][0] = *(const bf16x8*)(proj + (tk + 64 + kt * 16 + fr) * DIN + 256 + h * 64 + fq * 8);
                    Kc[kt][1] = *(const bf16x8*)(proj + (tk + 64 + kt * 16 + fr) * DIN + 256 + h * 64 + 32 + fq * 8);
                }
            }
            const int relbase = (j - 8) * 64 - (qh * 32 + fr) + fq * 4;
#pragma unroll
            for (int qt = 0; qt < 2; ++qt) {
                float mx = -1e30f;
#pragma unroll
                for (int kt = 0; kt < 4; ++kt)
#pragma unroll
                    for (int jj = 0; jj < 4; ++jj) {
                        int rel = relbase + kt * 16 + jj - qt * 16;
                        rel = rel < -256 ? -256 : (rel > 256 ? 256 : rel);
                        const float s = S[kt][qt][jj] * 0.125f + sbh[rel + 256];
                        S[kt][qt][jj] = s; mx = fmaxf(mx, s);
                    }
                mx = fmaxf(mx, shx(mx, lane, 16)); mx = fmaxf(mx, shx(mx, lane, 32));
                const float mn = fmaxf(mrun[qt], mx);
                const float alpha = __expf(mrun[qt] - mn);
                mrun[qt] = mn;
                float ps = 0.f;
#pragma unroll
                for (int kt = 0; kt < 4; ++kt)
#pragma unroll
                    for (int jj = 0; jj < 4; ++jj) { const float pv = __expf(S[kt][qt][jj] - mn); S[kt][qt][jj] = pv; ps += pv; }
                lsum[qt] = lsum[qt] * alpha + ps;
#pragma unroll
                for (int dt = 0; dt < 4; ++dt) O[dt][qt] *= alpha;
            }
#pragma unroll
            for (int gk = 0; gk < 2; ++gk) {
                bf16x8 Pf[2];
#pragma unroll
                for (int qt = 0; qt < 2; ++qt) {
                    union { unsigned u[4]; bf16x8 v; } cv;
                    cv.u[0] = pk_bf16(S[2 * gk][qt][0], S[2 * gk][qt][1]); cv.u[1] = pk_bf16(S[2 * gk][qt][2], S[2 * gk][qt][3]);
                    cv.u[2] = pk_bf16(S[2 * gk + 1][qt][0], S[2 * gk + 1][qt][1]); cv.u[3] = pk_bf16(S[2 * gk + 1][qt][2], S[2 * gk + 1][qt][3]);
                    Pf[qt] = cv.v;
                }
#pragma unroll
                for (int dt = 0; dt < 4; ++dt) {
                    const bf16_t* vp = vT + ((cur * 4 + h) * 64 + dt * 16 + fr) * 68 + gk * 32 + fq * 4;
                    union { uint2 u[2]; bf16x8 v; } vv;
                    vv.u[0] = *(const uint2*)vp; vv.u[1] = *(const uint2*)(vp + 16);
                    O[dt][0] = __builtin_amdgcn_mfma_f32_16x16x32_bf16(vv.v, Pf[0], O[dt][0], 0, 0, 0);
                    O[dt][1] = __builtin_amdgcn_mfma_f32_16x16x32_bf16(vv.v, Pf[1], O[dt][1], 0, 0, 0);
                }
            }
            __syncthreads();
        }
#pragma unroll
        for (int qt = 0; qt < 2; ++qt) {
            float lt = lsum[qt];
            lt += shx(lt, lane, 16); lt += shx(lt, lane, 32);
            const float inv = 1.0f / lt;
            bf16_t* orow = mix + (tq + qh * 32 + qt * 16 + fr) * 1024 + h * 64 + fq * 4;
#pragma unroll
            for (int dt = 0; dt < 4; ++dt) {
                uint2 wv; wv.x = pk_bf16(O[dt][qt][0] * inv, O[dt][qt][1] * inv); wv.y = pk_bf16(O[dt][qt][2] * inv, O[dt][qt][3] * inv);
                *(uint2*)(orow + dt * 16) = wv;
            }
        }
    }
    __syncthreads();
}

__device__ __forceinline__ void hgrn_m1(const Params& p, const Ctx& cx, int l) {
    extern __shared__ __attribute__((aligned(16))) bf16_t shm[];
    const int wave = cx.tid >> 6, lane = cx.tid & 63;
    float* sl = (float*)shm + wave * 3072;
    const bf16_t* proj = (const bf16_t*)(cx.ws + OFF_PH);
    bf16_t* mix = (bf16_t*)(cx.ws + OFF_MIX);
    float* U = (float*)(cx.ws + OFF_HU);
    float* dec = (float*)(cx.ws + OFF_SM + SM_DEC);
    const float* lbp = (const float*)(cx.ws + OFF_SM + SM_LB) + l * 256;
    for (int it = cx.bid * 8 + wave; it < 2048; it += cx.nb * 8) {
        const int bh = it >> 7, c = it & 127, b = bh >> 2, h = bh & 3;
        const size_t t0 = (size_t)b * SEQ + c * 64;
        const float lb = lbp[h * 64 + lane];
        f32x2 L[32];
#pragma unroll
        for (int k = 0; k < 32; ++k) L[k] = (f32x2){0.f, 0.f};
        float D = 1.f;
        for (int sub = 0; sub < 4; ++sub) {
            bf16_t qraw[16], fraw[16], iraw[16];
#pragma unroll
            for (int tt = 0; tt < 16; ++tt) {
                const bf16_t* row = proj + (t0 + sub * 16 + tt) * DIN + 768 + h * 64 + lane;
                qraw[tt] = row[0]; fraw[tt] = row[256]; iraw[tt] = row[512];
            }
#pragma unroll
            for (int tt = 0; tt < 16; ++tt) {
                const float qr = bf2f(qraw[tt]), fr_ = bf2f(fraw[tt]);
                const float e = __expf(-fr_), sg = 1.0f / (1.0f + e);
                const float f = lb + (1.f - lb) * sg, key = (1.f - lb) * e * sg;
                D *= f;
                sl[tt * 192 + lane] = f; sl[tt * 192 + 64 + lane] = key; sl[tt * 192 + 128 + lane] = qr * sigm(qr);
            }
            __builtin_amdgcn_fence(__ATOMIC_RELEASE, "wavefront");
            __builtin_amdgcn_wave_barrier();
#pragma unroll
            for (int tt = 0; tt < 16; ++tt) {
                const size_t t = t0 + sub * 16 + tt;
                const float iv = bf2f(iraw[tt]);
                const f32x2 iv2 = (f32x2){iv, iv};
                f32x2 o2 = (f32x2){0.f, 0.f};
                const float* sr = sl + tt * 192;
#pragma unroll
                for (int j = 0; j < 16; ++j) {
                    const f32x4 f4 = *(const f32x4*)(sr + 4 * j), k4 = *(const f32x4*)(sr + 64 + 4 * j), q4 = *(const f32x4*)(sr + 128 + 4 * j);
                    L[2 * j] = (f32x2){f4[0], f4[1]} * L[2 * j] + (f32x2){k4[0], k4[1]} * iv2;
                    o2 += (f32x2){q4[0], q4[1]} * L[2 * j];
                    L[2 * j + 1] = (f32x2){f4[2], f4[3]} * L[2 * j + 1] + (f32x2){k4[2], k4[3]} * iv2;
                    o2 += (f32x2){q4[2], q4[3]} * L[2 * j + 1];
                }
                mix[t * 1024 + 256 + h * 64 + lane] = f2bf(o2[0] + o2[1]);
            }
            __builtin_amdgcn_fence(__ATOMIC_RELEASE, "wavefront");
            __builtin_amdgcn_wave_barrier();
        }
#pragma unroll
        for (int k = 0; k < 32; ++k) { U[(size_t)it * 4096 + (2 * k) * 64 + lane] = L[k][0]; U[(size_t)it * 4096 + (2 * k + 1) * 64 + lane] = L[k][1]; }
        dec[it * 64 + lane] = D;
    }
    __syncthreads();
}

__device__ __forceinline__ void hgrn_m3(const Params& p, const Ctx& cx, int l, bool dry = false) {
    extern __shared__ __attribute__((aligned(16))) bf16_t shm[];
    const int wave = cx.tid >> 6, lane = cx.tid & 63;
    float* sl = (float*)shm + wave * 1024;
    const bf16_t* proj = (const bf16_t*)(cx.ws + OFF_PH);
    bf16_t* mix = (bf16_t*)(cx.ws + OFF_MIX);
    const float* U = (const float*)(cx.ws + OFF_HU);
    const float* lbp = (const float*)(cx.ws + OFF_SM + SM_LB) + l * 256;
    for (int it = cx.bid * 8 + wave; it < 2048; it += cx.nb * 8) {
        const int bh = it >> 7, c = it & 127, b = bh >> 2, h = bh & 3;
        const size_t t0 = (size_t)b * SEQ + c * 64;
        const float lb = lbp[h * 64 + lane];
        const float hn = p.in[9 + cx.z][l * 256 + h * 64 + lane];
        float S[64];
#pragma unroll
        for (int k = 0; k < 64; ++k) S[k] = U[(size_t)it * 4096 + k * 64 + lane];
        float G = 1.f;
        for (int sub = 0; sub < 4; ++sub) {
            bf16_t qraw[16], fraw[16], graw[16], oraw[16];
#pragma unroll
            for (int tt = 0; tt < 16; ++tt) {
                const size_t t = t0 + sub * 16 + tt;
                const bf16_t* row = proj + t * DIN + 768 + h * 64 + lane;
                qraw[tt] = row[0]; fraw[tt] = row[256]; graw[tt] = row[768];
                oraw[tt] = mix[t * 1024 + 256 + h * 64 + lane];
            }
#pragma unroll
            for (int tt = 0; tt < 16; ++tt) {
                const float qr = bf2f(qraw[tt]), fr_ = bf2f(fraw[tt]);
                const float f = lb + (1.f - lb) * sigm(fr_);
                G *= f;
                sl[tt * 64 + lane] = qr * sigm(qr) * G;
            }
            __builtin_amdgcn_fence(__ATOMIC_RELEASE, "wavefront");
            __builtin_amdgcn_wave_barrier();
#pragma unroll
            for (int tt = 0; tt < 16; ++tt) {
                const size_t t = t0 + sub * 16 + tt;
                const float* sr = sl + tt * 64;
                float o = 0.f;
#pragma unroll
                for (int j = 0; j < 16; ++j) {
                    const f32x4 q4 = *(const f32x4*)(sr + 4 * j);
                    o += q4[0] * S[4 * j] + q4[1] * S[4 * j + 1] + q4[2] * S[4 * j + 2] + q4[3] * S[4 * j + 3];
                }
                const size_t idx = t * 1024 + 256 + h * 64 + lane;
                o += bf2f(oraw[tt]);
                const float ms = wave_sum(o * o) * (1.0f / 64.0f);
                const float gr = bf2f(graw[tt]);
                if (!dry || ms == 1.2345e33f) mix[idx] = f2bf(o * rsqrtf(ms + 1e-6f) * hn * gr * sigm(gr));
            }
            __builtin_amdgcn_fence(__ATOMIC_RELEASE, "wavefront");
            __builtin_amdgcn_wave_barrier();
        }
    }
    __syncthreads();
}

__device__ __forceinline__ void rwkv_pre(const Params& p, const Ctx& cx, int l) {
    extern __shared__ __attribute__((aligned(16))) bf16_t shm[];
    float* wl = (float*)shm + (cx.tid >> 6) * 64;
    const int w = cx.tid >> 6, lane = cx.tid & 63, h = w & 3, th = w >> 2, c = h * 64 + lane;
    const bf16_t* proj = (const bf16_t*)(cx.ws + OFF_PH);
    bf16_t* RW = (bf16_t*)(cx.ws + OFF_RW);
    float w2c[32], a2c[32];
#pragma unroll
    for (int j = 0; j < 32; ++j) { w2c[j] = p.in[12 + cx.z][(l * 32 + j) * 256 + c]; a2c[j] = p.in[14 + cx.z][(l * 32 + j) * 256 + c]; }
    const float w0 = p.in[11 + cx.z][l * 256 + c], a0 = p.in[13 + cx.z][l * 256 + c], kkc = p.in[16 + cx.z][l * 256 + c], kac = p.in[17 + cx.z][l * 256 + c];
    const float* mu = p.in[10 + cx.z] + l * 896;
    const float mu_r = mu[c], mu_k = mu[256 + c], mu_v = mu[512 + c], mu_lo = mu[768 + lane];
    for (int tile = cx.bid; tile < 1024; tile += cx.nb) {
        const int tbase = tile * 32 + th * 16;
        bf16_t cr[17], ck[17], cv[17], cl[17];
#pragma unroll
        for (int i = 0; i < 17; ++i) {
            const bf16_t* rp = proj + (size_t)(tbase + i - 1) * DIN + 1792;
            if (i == 0 && (tbase & (SEQ - 1)) == 0) { cr[i] = 0; ck[i] = 0; cv[i] = 0; cl[i] = 0; }
            else { cr[i] = rp[c]; ck[i] = rp[256 + c]; cv[i] = rp[512 + c]; cl[i] = rp[768 + lane]; }
        }
        float Dc = 1.0f;
#pragma unroll
        for (int i = 0; i < 16; ++i) {
            const int t = tbase + i, s = t & (SEQ - 1), b = t >> 13;
            float x0, x1;
            x0 = bf2f(cr[i + 1]); x1 = bf2f(cr[i]); const float r = x0 + mu_r * (x1 - x0);
            x0 = bf2f(ck[i + 1]); x1 = bf2f(ck[i]); const float k = x0 + mu_k * (x1 - x0);
            x0 = bf2f(cv[i + 1]); x1 = bf2f(cv[i]); const float v = x0 + mu_v * (x1 - x0);
            x0 = bf2f(cl[i + 1]); x1 = bf2f(cl[i]); float lo = x0 + mu_lo * (x1 - x0);
            if (lane < 32) lo = 2.0f * sigm(2.0f * lo) - 1.0f;
            f32x2 ws2 = (f32x2){w0, 0.f}, as2 = (f32x2){a0, 0.f};
            wl[lane] = lo;
            __builtin_amdgcn_fence(__ATOMIC_RELEASE, "wavefront");
            __builtin_amdgcn_wave_barrier();
#pragma unroll
            for (int j4 = 0; j4 < 8; ++j4) {
                const f32x4 a4 = *(const f32x4*)(wl + 4 * j4), b4 = *(const f32x4*)(wl + 32 + 4 * j4);
                ws2 += (f32x2){a4[0], a4[1]} * (f32x2){w2c[4 * j4], w2c[4 * j4 + 1]}; ws2 += (f32x2){a4[2], a4[3]} * (f32x2){w2c[4 * j4 + 2], w2c[4 * j4 + 3]};
                as2 += (f32x2){b4[0], b4[1]} * (f32x2){a2c[4 * j4], a2c[4 * j4 + 1]}; as2 += (f32x2){b4[2], b4[3]} * (f32x2){a2c[4 * j4 + 2], a2c[4 * j4 + 3]};
            }
            __builtin_amdgcn_wave_barrier();
            const float wsum = ws2[0] + ws2[1], asum = as2[0] + as2[1];
            const float nx = -wsum;
            const float sp = fmaxf(nx, 0.f) + __logf(1.0f + __expf(-fabsf(nx)));
            const float wpre = -sp - 0.5f;
            const float omw = 1.0f - __expf(-__expf(wpre));
            const float a = sigm(asum);
            const float kkr = k * kkc;
            const float ssq = wave_sum(kkr * kkr);
            const float kk = kkr * fminf(__builtin_amdgcn_rsqf(ssq), 1e12f);
            const float kmod = k * (1.f + (a - 1.f) * kac);
            bf16_t* o = RW + (((size_t)(b * 4 + h) * SEQ + s) * 6) * 64 + lane;
            const float Dp = Dc;
            Dc *= (1.0f - omw);
            const float iD = __builtin_amdgcn_rcpf(Dc);
            o[0] = f2bf(r * Dc); o[64] = f2bf(Dc > 0.5f ? (Dc - 1.0f) : Dc);     o[128] = f2bf(kmod * iD); o[192] = f2bf(-kk * Dp); o[256] = f2bf(kk * a * iD); o[320] = f2bf(v);
        }
    }
    __syncthreads();
}

__device__ __forceinline__ void rwkv_post(const Params& p, const Ctx& cx, int l, bool dry = false) {
    extern __shared__ __attribute__((aligned(16))) bf16_t shm[];
    float* wl = (float*)shm + (cx.tid >> 6) * 64;
    const int w = cx.tid >> 6, lane = cx.tid & 63, h = w & 3, th = w >> 2, c = h * 64 + lane;
    const bf16_t* proj = (const bf16_t*)(cx.ws + OFF_PH);
    const bf16_t* RW = (const bf16_t*)(cx.ws + OFF_RW);
    bf16_t* mix = (bf16_t*)(cx.ws + OFF_MIX);
    float g2c[64];
#pragma unroll
    for (int j = 0; j < 64; ++j) g2c[j] = p.in[15 + cx.z][(l * 64 + j) * 256 + c];
    const float lnw = p.in[19 + cx.z][l * 256 + c], lnb = p.in[20 + cx.z][l * 256 + c], rk = p.in[18 + cx.z][l * 256 + c];
    const float mu_g = p.in[10 + cx.z][l * 896 + 832 + lane];
    for (int tile = cx.bid; tile < 1024; tile += cx.nb) {
        const int tbase = tile * 32 + th * 16;
        bf16_t cg_[17], yr[16], ar[16], ak[16], av[16];
#pragma unroll
        for (int i = 0; i < 17; ++i) {
            if (i == 0 && (tbase & (SEQ - 1)) == 0) cg_[i] = 0;
            else cg_[i] = proj[(size_t)(tbase + i - 1) * DIN + 1792 + 832 + lane];
        }
#pragma unroll
        for (int i = 0; i < 16; ++i) {
            const int t = tbase + i, s = t & (SEQ - 1), b = t >> 13;
            yr[i] = mix[(size_t)t * 1024 + 512 + c];
            const bf16_t* a = RW + (((size_t)(b * 4 + h) * SEQ + s) * 6) * 64 + lane;
            ar[i] = a[0]; ak[i] = a[128]; av[i] = a[320];
        }
#pragma unroll
        for (int i = 0; i < 16; ++i) {
            const int t = tbase + i;
            const float x0 = bf2f(cg_[i + 1]), x1 = bf2f(cg_[i]);
            const float gl = sigm(x0 + mu_g * (x1 - x0));
            f32x2 g2 = (f32x2){0.f, 0.f};
            wl[lane] = gl;
            __builtin_amdgcn_fence(__ATOMIC_RELEASE, "wavefront");
            __builtin_amdgcn_wave_barrier();
#pragma unroll
            for (int j4 = 0; j4 < 16; ++j4) {
                const f32x4 a4 = *(const f32x4*)(wl + 4 * j4);
                g2 += (f32x2){a4[0], a4[1]} * (f32x2){g2c[4 * j4], g2c[4 * j4 + 1]}; g2 += (f32x2){a4[2], a4[3]} * (f32x2){g2c[4 * j4 + 2], g2c[4 * j4 + 3]};
            }
            __builtin_amdgcn_wave_barrier();
            const float g = g2[0] + g2[1];
            const size_t idx = (size_t)t * 1024 + 512 + c;
            const float y = bf2f(yr[i]);
            const float mean = wave_sum(y) * (1.0f / 64.0f);
            const float dlt = y - mean;
            const float var = wave_sum(dlt * dlt) * (1.0f / 64.0f);
            const float yn = dlt * rsqrtf(var + 64e-5f) * lnw + lnb;
            const float r = bf2f(ar[i]), km = bf2f(ak[i]), v = bf2f(av[i]);
            const float bonus = wave_sum(r * km * rk) * v;
            if (!dry || g == 1.2345e33f) mix[idx] = f2bf((yn + bonus) * g);
        }
    }
    __syncthreads();
}

__device__ __forceinline__ void rwkv_scan(const Params& p, const Ctx& cx, int l, int unit) {
    extern __shared__ __attribute__((aligned(16))) bf16_t shm[];
    float* buf = (float*)shm;
    float* ybuf = (float*)shm + 2 * 12288;
    const int tid = cx.tid, lane = tid & 63, wv = tid >> 6;
    const bool scan = tid < 256;
    const int lt = tid - 256;
    const bf16_t* RW = (const bf16_t*)(cx.ws + OFF_RW);
    bf16_t* mix = (bf16_t*)(cx.ws + OFF_MIX);
    const int chain = unit >> 2, qr = unit & 3, b = chain >> 2, h = chain & 3;
    const unsigned* src0 = (const unsigned*)(RW + (size_t)chain * SEQ * 384);
    uint2 pre[24];
    const int grp = lt >> 7, l2 = lt & 127;
    if (!scan) {
        const uint2* s2 = (const uint2*)src0;
        if (grp == 1) {
#pragma unroll
            for (int j = 0; j < 24; ++j) pre[j] = s2[l2 + 128 * j];
#pragma unroll
            for (int j = 0; j < 24; ++j) { const uint2 u = pre[j]; ((float4*)buf)[l2 + 128 * j] = make_float4(__uint_as_float(u.x << 16), __uint_as_float(u.x & 0xffff0000u), __uint_as_float(u.y << 16), __uint_as_float(u.y & 0xffff0000u)); }
#pragma unroll
            for (int j = 0; j < 24; ++j) pre[j] = s2[3072 + l2 + 128 * j];
        } else {
#pragma unroll
            for (int j = 0; j < 24; ++j) pre[j] = s2[2 * 3072 + l2 + 128 * j];
        }
    }
    __syncthreads();
    const int g4 = lane >> 4, q = lane & 15, rloc = wv * 4 + g4, row = qr * 16 + rloc;
    f32x2 s01 = (f32x2){0.f, 0.f}, s23 = (f32x2){0.f, 0.f};
    for (int nb = 0; nb < 256; ++nb) {
        const int cur = nb & 1;
        if (scan) {
            const float* bb = buf + cur * 12288;
            float ysel0 = 0.f, ysel1 = 0.f, yp = 0.f;
            f32x4 r4 = *(const f32x4*)(bb + 4 * q), w4 = *(const f32x4*)(bb + 64 + 4 * q), k4 = *(const f32x4*)(bb + 128 + 4 * q);
            f32x4 kk4 = *(const f32x4*)(bb + 192 + 4 * q), ka4 = *(const f32x4*)(bb + 256 + 4 * q);
            float v = bb[320 + row];
            f32x4 nr4 = *(const f32x4*)(bb + 384 + 4 * q), nw4 = *(const f32x4*)(bb + 384 + 64 + 4 * q), nk4 = *(const f32x4*)(bb + 384 + 128 + 4 * q);
            f32x4 nkk4 = *(const f32x4*)(bb + 384 + 192 + 4 * q), nka4 = *(const f32x4*)(bb + 384 + 256 + 4 * q);
            float nv = bb[384 + 320 + row];
#pragma unroll
            for (int i = 0; i < 32; ++i) {
                f32x4 mr4 = nr4, mw4 = nw4, mk4 = nk4, mkk4 = nkk4, mka4 = nka4; float mv = nv;
                if (i < 30) {
                    const float* tb = bb + (i + 2) * 384;
                    mr4 = *(const f32x4*)(tb + 4 * q); mw4 = *(const f32x4*)(tb + 64 + 4 * q); mk4 = *(const f32x4*)(tb + 128 + 4 * q);
                    mkk4 = *(const f32x4*)(tb + 192 + 4 * q); mka4 = *(const f32x4*)(tb + 256 + 4 * q); mv = tb[320 + row];
                }
                const f32x2 d2 = s01 * (f32x2){kk4[0], kk4[1]} + s23 * (f32x2){kk4[2], kk4[3]};
                float dA = d2[0] + d2[1];
                float yB = yp;
                f32x2 t01, t23;
                dA += dpp_f<0xB1>(dA);  yB += dpp_f<0xB1>(yB);  t01 = s01 + (f32x2){v, v} * (f32x2){k4[0], k4[1]};
                dA += dpp_f<0x4E>(dA);  yB += dpp_f<0x4E>(yB);  t23 = s23 + (f32x2){v, v} * (f32x2){k4[2], k4[3]};
                dA += dpp_f<0x141>(dA); yB += dpp_f<0x141>(yB);
                dA += dpp_f<0x140>(dA); yB += dpp_f<0x140>(yB);
                if (i > 0) { if (i <= 16) ysel0 = (q == i - 1) ? yB : ysel0; else ysel1 = (q == i - 17) ? yB : ysel1; }
                s01 = t01 + (f32x2){dA, dA} * (f32x2){ka4[0], ka4[1]};
                s23 = t23 + (f32x2){dA, dA} * (f32x2){ka4[2], ka4[3]};
                const f32x2 y2 = s01 * (f32x2){r4[0], r4[1]} + s23 * (f32x2){r4[2], r4[3]};
                yp = y2[0] + y2[1];
                if ((i & 15) == 15) {
                    const float d0 = w4[0] < 0.f ? 1.0f + w4[0] : w4[0], d1 = w4[1] < 0.f ? 1.0f + w4[1] : w4[1];
                    const float d2_ = w4[2] < 0.f ? 1.0f + w4[2] : w4[2], d3 = w4[3] < 0.f ? 1.0f + w4[3] : w4[3];
                    s01 = s01 * (f32x2){d0, d1}; s23 = s23 * (f32x2){d2_, d3};
                }
                r4 = nr4; w4 = nw4; k4 = nk4; kk4 = nkk4; ka4 = nka4; v = nv;
                nr4 = mr4; nw4 = mw4; nk4 = mk4; nkk4 = mkk4; nka4 = mka4; nv = mv;
            }
            { const float yl = row16_sum(yp); ysel1 = (q == 15) ? yl : ysel1; }
            ybuf[cur * 512 + q * 16 + rloc] = ysel0;
            ybuf[cur * 512 + (16 + q) * 16 + rloc] = ysel1;
        } else {
            if (grp == ((nb + 1) & 1)) {
                if (nb + 1 < 256) {
                    float4* dst = (float4*)(buf + (cur ^ 1) * 12288);
#pragma unroll
                    for (int j = 0; j < 24; ++j) { const uint2 u = pre[j]; dst[l2 + 128 * j] = make_float4(__uint_as_float(u.x << 16), __uint_as_float(u.x & 0xffff0000u), __uint_as_float(u.y << 16), __uint_as_float(u.y & 0xffff0000u)); }
                }
                if (nb + 3 < 256) {
                    const uint2* src = (const uint2*)src0 + (size_t)(nb + 3) * 3072;
#pragma unroll
                    for (int j = 0; j < 24; ++j) pre[j] = src[l2 + 128 * j];
                }
            }
            if (nb > 0 && lt < 128) {
                const f32x4 yv = *(const f32x4*)(ybuf + (cur ^ 1) * 512 + lt * 4);
                uint2 wv2; wv2.x = pk_bf16(yv[0], yv[1]); wv2.y = pk_bf16(yv[2], yv[3]);
                *(uint2*)(mix + ((size_t)b * SEQ + (nb - 1) * 32 + (lt >> 2)) * 1024 + 512 + h * 64 + qr * 16 + (lt & 3) * 4) = wv2;
            }
        }
        __syncthreads();
    }
    if (!scan && lt < 128) {
        const f32x4 yv = *(const f32x4*)(ybuf + 512 + lt * 4);
        uint2 wv2; wv2.x = pk_bf16(yv[0], yv[1]); wv2.y = pk_bf16(yv[2], yv[3]);
        *(uint2*)(mix + ((size_t)b * SEQ + 255 * 32 + (lt >> 2)) * 1024 + 512 + h * 64 + qr * 16 + (lt & 3) * 4) = wv2;
    }
    __syncthreads();
}

__device__ __forceinline__ void lru_carry_wave(const Ctx& cx, int chain) {
    const float* hend = (const float*)(cx.ws + OFF_SM + SM_HEND);
    const float* ptot = (const float*)(cx.ws + OFF_SM + SM_PTOT);
    float* carry = (float*)(cx.ws + OFF_SM + SM_CARRY);
    const int lane = cx.tid & 63, bb = chain >> 8, e = chain & 255;
    float P[4], H[4];
#pragma unroll
    for (int k = 0; k < 4; ++k) { const int ix = (bb * 256 + lane * 4 + k) * 256 + e; P[k] = ptot[ix]; H[k] = hend[ix]; }
    float A = 1.f, B = 0.f;
#pragma unroll
    for (int k = 0; k < 4; ++k) { B = P[k] * B + H[k]; A = P[k] * A; }
#pragma unroll
    for (int d = 1; d < 64; d <<= 1) {
        const float Ap = __int_as_float(__builtin_amdgcn_ds_bpermute(((lane - d) & 63) << 2, __float_as_int(A)));
        const float Bp = __int_as_float(__builtin_amdgcn_ds_bpermute(((lane - d) & 63) << 2, __float_as_int(B)));
        if (lane >= d) { B = A * Bp + B; A = A * Ap; }
    }
    float x = __int_as_float(__builtin_amdgcn_ds_bpermute(((lane - 1) & 63) << 2, __float_as_int(B)));
    if (lane == 0) x = 0.f;
#pragma unroll
    for (int k = 0; k < 4; ++k) { carry[(bb * 256 + lane * 4 + k) * 256 + e] = x; x = P[k] * x + H[k]; }
}

__device__ __forceinline__ void hgrn_state_scan(const Params& p, const Ctx& cx) {
    float* U = (float*)(cx.ws + OFF_HU);
    const float* dec = (const float*)(cx.ws + OFF_SM + SM_DEC);
    for (int g = cx.bid * 512 + cx.tid; g < 65536; g += cx.nb * 512) {
        const int bh = g >> 12, kv = g & 4095, k = kv >> 6;
        float run = 0.f;
        for (int c0 = 0; c0 < 128; c0 += 16) {
            float u[16], d[16];
#pragma unroll
            for (int j = 0; j < 16; ++j) { const int it = bh * 128 + c0 + j; u[j] = U[(size_t)it * 4096 + kv]; d[j] = dec[it * 64 + k]; }
#pragma unroll
            for (int j = 0; j < 16; ++j) { const int it = bh * 128 + c0 + j; U[(size_t)it * 4096 + kv] = run; run = d[j] * run + u[j]; }
        }
    }
}

__device__ __forceinline__ void lru_m1(const Params& p, const Ctx& cx, int l) {
    extern __shared__ __attribute__((aligned(16))) bf16_t shm[];
    float* conv = (float*)shm;
    const int tid = cx.tid, e = tid & 255, half = tid >> 8, n = e >> 6;
    const bf16_t* proj = (const bf16_t*)(cx.ws + OFF_PH);
    bf16_t* hl = (bf16_t*)cx.out;
    float* Pb = (float*)((char*)cx.out + 16 * MiB);
    float* hend = (float*)(cx.ws + OFF_SM + SM_HEND);
    float* ptot = (float*)(cx.ws + OFF_SM + SM_PTOT);
    float wa[64], wx[64];
#pragma unroll
    for (int d = 0; d < 64; ++d) { wa[d] = p.in[23 + cx.z][((l * 4 + n) * 64 + d) * 64 + (e & 63)]; wx[d] = p.in[25 + cx.z][((l * 4 + n) * 64 + d) * 64 + (e & 63)]; }
    const float cw0 = p.in[21 + cx.z][(l * 4 + 0) * 256 + e], cw1 = p.in[21 + cx.z][(l * 4 + 1) * 256 + e], cw2 = p.in[21 + cx.z][(l * 4 + 2) * 256 + e], cw3 = p.in[21 + cx.z][(l * 4 + 3) * 256 + e];
    const float cb = p.in[22 + cx.z][l * 256 + e], ba = p.in[24 + cx.z][l * 256 + e], bx = p.in[26 + cx.z][l * 256 + e];
    const float lam = p.in[27 + cx.z][l * 256 + e];
    const float spl = log1pf(__expf(-lam));
    for (int item = cx.bid; item < 512; item += cx.nb) {
        const int b = item >> 7, ch = item & 127;
        const int s0 = ch * 64 + half * 32;
        const size_t tb = (size_t)b * SEQ;
        __syncthreads();
        {
            float xm3 = (s0 >= 3) ? bf2f(proj[(tb + s0 - 3) * DIN + 2688 + e]) : 0.f;
            float xm2 = (s0 >= 2) ? bf2f(proj[(tb + s0 - 2) * DIN + 2688 + e]) : 0.f;
            float xm1 = (s0 >= 1) ? bf2f(proj[(tb + s0 - 1) * DIN + 2688 + e]) : 0.f;
            bf16_t xr[32];
#pragma unroll
            for (int tt = 0; tt < 32; ++tt) xr[tt] = proj[(tb + s0 + tt) * DIN + 2688 + e];
#pragma unroll
            for (int tt = 0; tt < 32; ++tt) {
                const float x0 = bf2f(xr[tt]);
                conv[(half * 32 + tt) * 256 + e] = cb + cw0 * xm3 + cw1 * xm2 + cw2 * xm1 + cw3 * x0;
                xm3 = xm2; xm2 = xm1; xm1 = x0;
            }
        }
        __syncthreads();
        float hst = 0.f, P = 1.f;
        for (int tt = 0; tt < 32; ++tt) {
            const int tl = half * 32 + tt;
            const float* cr = conv + tl * 256 + n * 64;
            float ga = ba, gx = bx;
#pragma unroll
            for (int d4 = 0; d4 < 16; ++d4) {
                const f32x4 c4 = *(const f32x4*)(cr + 4 * d4);
                ga += c4[0] * wa[4 * d4] + c4[1] * wa[4 * d4 + 1] + c4[2] * wa[4 * d4 + 2] + c4[3] * wa[4 * d4 + 3];
                gx += c4[0] * wx[4 * d4] + c4[1] * wx[4 * d4 + 1] + c4[2] * wx[4 * d4 + 2] + c4[3] * wx[4 * d4 + 3];
            }
            const float cv = conv[tl * 256 + e];
            const float la = -8.0f * sigm(ga) * spl;
            const float a = __expf(la);
            const float inp = __builtin_amdgcn_sqrtf(fmaxf(1.0f - a * a, 0.f)) * (sigm(gx) * cv);
            hst = a * hst + inp; P *= a;
            const size_t t = tb + s0 + tt;
            hl[t * 256 + e] = f2bf(hst); Pb[t * 256 + e] = P;
        }
        const int sc = ch * 2 + half;
        hend[(b * 256 + sc) * 256 + e] = hst; ptot[(b * 256 + sc) * 256 + e] = P;
    }
    __syncthreads();
}

__device__ __forceinline__ void lru_m3(const Params& p, const Ctx& cx, int l, bool dry = false) {
    const bf16_t* proj = (const bf16_t*)(cx.ws + OFF_PH);
    const bf16_t* hl = (const bf16_t*)cx.out;
    const float* Pb = (const float*)((const char*)cx.out + 16 * MiB);
    const float* carry = (const float*)(cx.ws + OFF_SM + SM_CARRY);
    bf16_t* mix = (bf16_t*)(cx.ws + OFF_MIX);
    const int stride = cx.nb * 512;
    for (int g0 = cx.bid * 512 + cx.tid; g0 < T * 64; g0 += 4 * stride) {
        uint2 hv[4], gv[4]; float4 pv[4], cv[4];
#pragma unroll
        for (int u = 0; u < 4; ++u) {
            const int g = g0 + u * stride;
            if (g < T * 64) {
                const int t = g >> 6, e4 = (g & 63) * 4, b = t >> 13, s_ = t & (SEQ - 1), sc = s_ >> 5;
                hv[u] = *(const uint2*)(hl + (size_t)t * 256 + e4);
                pv[u] = *(const float4*)(Pb + (size_t)t * 256 + e4);
                cv[u] = *(const float4*)(carry + (b * 256 + sc) * 256 + e4);
                gv[u] = *(const uint2*)(proj + (size_t)t * DIN + 2944 + e4);
            }
        }
#pragma unroll
        for (int u = 0; u < 4; ++u) {
            const int g = g0 + u * stride;
            if (g < T * 64) {
                const int t = g >> 6, e4 = (g & 63) * 4;
                float hh[4] = { __uint_as_float(hv[u].x << 16) + pv[u].x * cv[u].x, __uint_as_float(hv[u].x & 0xffff0000u) + pv[u].y * cv[u].y,
                                __uint_as_float(hv[u].y << 16) + pv[u].z * cv[u].z, __uint_as_float(hv[u].y & 0xffff0000u) + pv[u].w * cv[u].w };
                const float gg[4] = { __uint_as_float(gv[u].x << 16), __uint_as_float(gv[u].x & 0xffff0000u), __uint_as_float(gv[u].y << 16), __uint_as_float(gv[u].y & 0xffff0000u) };
#pragma unroll
                for (int j = 0; j < 4; ++j) {
                    const float x = gg[j];
                    hh[j] *= x * sigm(1.5957691216057308f * (x + 0.044715f * x * x * x));
                }
                uint2 wv; wv.x = pk_bf16(hh[0], hh[1]); wv.y = pk_bf16(hh[2], hh[3]);
                *(uint2*)(mix + (size_t)t * 1024 + 768 + e4) = wv;
            }
        }
    }
}

__device__ __forceinline__ void wb_arrive(const Ctx& cx) {
    asm volatile("s_waitcnt vmcnt(0)" ::: "memory");
    __syncthreads();
    if (cx.tid == 0) {
        unsigned* c = (unsigned*)(cx.ws + OFF_SM + SM_CNT);
        __builtin_amdgcn_fence(__ATOMIC_RELEASE, "agent");
        asm volatile("s_waitcnt vmcnt(0)" ::: "memory");
        (void)__hip_atomic_fetch_add(c, 1u, __ATOMIC_RELAXED, __HIP_MEMORY_SCOPE_AGENT);
    }
}
__device__ __forceinline__ void wb_wait(const Ctx& cx, unsigned want) {
    asm volatile("s_waitcnt vmcnt(0)" ::: "memory");
    __syncthreads();
    if (cx.tid == 0) {
        unsigned* c = (unsigned*)(cx.ws + OFF_SM + SM_CNT);
        unsigned spins = 0;
        while (__hip_atomic_load(c, __ATOMIC_RELAXED, __HIP_MEMORY_SCOPE_AGENT) < want) { __builtin_amdgcn_s_sleep(1); if (++spins > (1u << 22)) break; }
        __builtin_amdgcn_fence(__ATOMIC_ACQUIRE, "agent");
        asm volatile("s_waitcnt vmcnt(0)" ::: "memory");
    }
    __syncthreads();
}
__device__ __forceinline__ void phase_mix(const Params& p, const Ctx& cx, int l) {
    if (cx.bid < 64) { rwkv_scan(p, cx, l, cx.bid); }
    else {
        Ctx cw = cx; cw.bid = cx.bid - 64; cw.nb = 192;
        attn_phase(p, cw, l); hgrn_m1(p, cw, l); lru_m1(p, cw, l);
        int tlc = 0;
        wb_arrive(cx);
        if (l < 3) { phase_convw(p, cw, l + 1, tlc, tlc + 1152); tlc += 1152; }
        wb_wait(cx, 192u * (unsigned)(2 * l + 1));
        if (cw.bid < 128) { Ctx cs = cw; cs.nb = 128; hgrn_state_scan(p, cs); }
        else { const int c0 = (cw.bid - 128) * 16 + (cx.tid >> 6) * 2; lru_carry_wave(cx, c0); lru_carry_wave(cx, c0 + 1); }
        wb_arrive(cx);
        if (l < 3) { phase_convw(p, cw, l + 1, tlc, tlc + 1152); tlc += 1152; }
        wb_wait(cx, 192u * (unsigned)(2 * l + 2));
        hgrn_m3(p, cw, l); lru_m3(p, cw, l);
        if (l < 3) phase_convw(p, cw, l + 1, tlc, 3136);
    }
}

constexpr int PPL = 9;
constexpr int N_PHASES = 1 + 4 * PPL;
__device__ __forceinline__ void run_phase(const Params& p, const Ctx& cx, int ph) {
    const bf16_t* xb = (const bf16_t*)(cx.ws + OFF_XB);
    const float* rinv = (const float*)(cx.ws + OFF_SM + SM_RINV);
    const bf16_t* gA = nullptr; const bf16_t* gB = nullptr; bf16_t* gO = nullptr; int gN = 0, gK = 0, gld = 0, gncv = 0, gepi = -1;
    if (ph == 0) { phase_row(p, cx, 0, 0); phase_convw(p, cx, 0); phase_lb(p, cx); }
    else {
        const int l = (ph - 1) / PPL, k = (ph - 1) % PPL;
        switch (k) {
        case 0: gA = xb; gB = (const bf16_t*)(wbase(cx, l) + OFF_WIN); gO = (bf16_t*)(cx.ws + OFF_PH); gN = DINP; gK = 1024; gld = DIN; gncv = DIN; gepi = EPI_PROJ; break;
        case 1: rwkv_pre(p, cx, l); break;
        case 2: phase_mix(p, cx, l); break;
        case 3: rwkv_post(p, cx, l); break;
        case 4: gA = (const bf16_t*)(cx.ws + OFF_MIX); gB = (const bf16_t*)(wbase(cx, l) + OFF_WOUT); gO = (bf16_t*)(cx.ws + OFF_PH); gN = 1024; gK = 1024; gld = 1024; gncv = 1024; gepi = EPI_FF; break;
        case 5: phase_row(p, cx, 1, l); break;
        case 6: gA = xb; gB = (const bf16_t*)(wbase(cx, l) + OFF_W1); gO = (bf16_t*)(cx.ws + OFF_PH); gN = 4096; gK = 1024; gld = 4096; gncv = 4096; gepi = EPI_UP; break;
        case 7: gA = (const bf16_t*)(cx.ws + OFF_PH); gB = (const bf16_t*)(wbase(cx, l) + OFF_W2); gO = (bf16_t*)(cx.ws + OFF_MIX); gN = 1024; gK = 4096; gld = 1024; gncv = 1024; gepi = EPI_FF; break;
        case 8: phase_row(p, cx, 2, l); break;
        }
    }
    if (gepi >= 0) gemm_phase(cx, gepi, gA, gB, T, gN, gK, gO, gld, gncv, rinv);
}

__global__ void __launch_bounds__(512, 2) fwd_kernel(Params p, int ph_lo, int ph_hi) {
    extern __shared__ __attribute__((aligned(16))) bf16_t shm[];
    cg::grid_group grid = cg::this_grid();
    volatile LAS unsigned* st = (volatile LAS unsigned*)((LAS char*)shm + 131072);
    if (threadIdx.x == 0) { st[0] = 0u; st[1] = 0u; }
    __syncthreads();
    unsigned* barw = (unsigned*)(p.ws + OFF_SM + SM_BAR);
    if (blockIdx.x == 0) for (int i = threadIdx.x; i < (16384 + 256) / 4; i += 512) barw[i] = 0u;
    XcdBarrier xb; xb.bar = barw; xb.x = xb_xcc_id(); xb.st = st;
    for (int ph = ph_lo; ph < ph_hi; ++ph) {
        Ctx cx;
        cx.tid = threadIdx.x; cx.bid = blockIdx.x; cx.nb = gridDim.x; cx.ws = p.ws; cx.out = p.out; cx.z = 0;
        asm volatile("" : "+v"(cx.tid));
        asm volatile("" : "+s"(cx.bid), "+s"(cx.nb), "+s"(cx.ws), "+s"(cx.out), "+s"(cx.z));
        run_phase(p, cx, ph);
        if (ph + 1 < ph_hi) { if (ph == ph_lo) { grid.sync(); if (threadIdx.x == 0) (void)xb_add(&barw[XB_XCNT(xb.x)], 1u); } else xcd_barrier(xb); }
    }
}

extern "C" void kernel_launch(void* const* d_in, const int* in_sizes, int n_in, void* d_out, int out_size, void* d_ws, size_t ws_size, hipStream_t stream) {
    static int grid_blocks = 0;
    if (!grid_blocks) {
        int dev = 0, cus = 0, per_cu = 0;
        (void)hipGetDevice(&dev);
        (void)hipDeviceGetAttribute(&cus, hipDeviceAttributeMultiprocessorCount, dev);
        (void)hipFuncSetAttribute((const void*)fwd_kernel, hipFuncAttributeMaxDynamicSharedMemorySize, LDS_BYTES);
        (void)hipOccupancyMaxActiveBlocksPerMultiprocessor(&per_cu, (const void*)fwd_kernel, 512, LDS_BYTES);
        if (per_cu < 1) per_cu = 1;
        grid_blocks = cus * per_cu;
        if (grid_blocks > 256) grid_blocks = 256;
        if (ws_size < 510 * MiB) fprintf(stderr, "kernel_launch: workspace too small: %zu\n", ws_size);
    }
    Params p{};
    for (int i = 0; i < 30; ++i) p.in[i] = (const float*)d_in[i];
    p.out = (float*)d_out; p.ws = (char*)d_ws;
#if MEGA
    int lo = 0, hi = N_PHASES;
    void* args[] = {&p, &lo, &hi};
    hipError_t e = hipLaunchCooperativeKernel((const void*)fwd_kernel, dim3(grid_blocks), dim3(512), args, LDS_BYTES, stream);
    if (e != hipSuccess) fprintf(stderr, "cooperative launch failed: %s (grid %d)\n", hipGetErrorString(e), grid_blocks);
#else
    for (int ph = 0; ph < N_PHASES; ++ph) hipLaunchKernelGGL(fwd_kernel, dim3(grid_blocks), dim3(512), LDS_BYTES, stream, p, ph, ph + 1);
#endif
}
```
